# Optimizing an MI355X kernel written in HIP

```python
import math
import jax, jax.numpy as jnp
from jax import lax
import numpy as np


D_MODEL = 1024
BATCH = 4
SEQ = 8192
DEPTH = 2

A_HEADS = 8
A_HEAD_DIM = 64
A_V_DIM = 2 * A_HEAD_DIM
A_WIDTH = A_HEADS * A_V_DIM
B_HEADS = 8
B_QK_DIM = 64
B_V_DIM = 128
B_WIDTH = B_HEADS * B_V_DIM
CONV_WIDTH = 4
CHUNK = 64
Q_BLOCK = 128
ROPE_THETA = 10000.0
EPS = 1e-6
NEG_INIT = -1e30

SPLITS = (
    A_HEADS * 2 * A_HEAD_DIM,
    A_HEADS * 2 * A_HEAD_DIM,
    A_WIDTH,
    A_WIDTH,
    2 * B_HEADS * B_QK_DIM,
    B_WIDTH,
    B_HEADS,
    B_HEADS,
    B_WIDTH,
    B_WIDTH,
    D_MODEL,
    D_MODEL,
)
D_IN = sum(SPLITS)

kernel_name = 'hybrid_diffattn_mlstm_gated_block'


def rmsnorm(x, g):
    xf = x.astype(jnp.float32)
    y = xf * lax.rsqrt(jnp.mean(xf * xf, axis=-1, keepdims=True) + EPS)
    return y.astype(x.dtype) * g


def rope(x, cos, sin):
    half = x.shape[-1] // 2
    x1, x2 = x[..., :half], x[..., half:]
    cos = cos.astype(x.dtype)
    sin = sin.astype(x.dtype)
    return jnp.concatenate([x1 * cos - x2 * sin, x2 * cos + x1 * sin], axis=-1)


def causal_conv(x, w, b):
    c = x.shape[-1]
    y = lax.conv_general_dilated(
        x, w[:, None, :].astype(x.dtype), window_strides=(1,), padding=[(CONV_WIDTH - 1, 0)],
        dimension_numbers=('NWC', 'WIO', 'NWC'), feature_group_count=c)
    return y + b


def diff_attention(q, k, v, lam):
    bsz, nh, s, _, dh = q.shape
    dv = v.shape[-1]
    nqb = s // Q_BLOCK
    scale = dh ** -0.5
    kpos = jnp.arange(s)

    def block(j):
        start = j * Q_BLOCK
        qb = lax.dynamic_slice_in_dim(q, start, Q_BLOCK, axis=2)
        sc = jnp.einsum('bhqrd,bhkrd->bhrqk', qb, k).astype(jnp.float32) * scale
        qpos = start + jnp.arange(Q_BLOCK)
        causal = kpos[None, :] <= qpos[:, None]
        p = jax.nn.softmax(jnp.where(causal, sc, -jnp.inf), axis=-1)
        a = p[:, :, 0] - lam * p[:, :, 1]
        return jnp.einsum('bhqk,bhkd->bhqd', a.astype(v.dtype), v)

    out = lax.map(block, jnp.arange(nqb))
    return jnp.transpose(out, (1, 2, 0, 3, 4)).reshape(bsz, nh, s, dv)


def mlstm_chunkwise(q, k, v, i_pre, f_pre):
    bsz, nh, s, dk = q.shape
    dv = v.shape[-1]
    nc = s // CHUNK
    f32 = jnp.float32
    q = q.astype(f32).reshape(bsz, nh, nc, CHUNK, dk) * (dk ** -0.5)
    k = k.astype(f32).reshape(bsz, nh, nc, CHUNK, dk)
    v = v.astype(f32).reshape(bsz, nh, nc, CHUNK, dv)
    ig = i_pre.astype(f32).reshape(bsz, nh, nc, CHUNK)
    b = jnp.cumsum(jax.nn.log_sigmoid(f_pre.astype(f32)).reshape(bsz, nh, nc, CHUNK), axis=-1)
    b_last = b[..., -1]
    w_log = b_last[..., None] - b + ig
    m_loc = jnp.max(w_log, axis=-1)
    wk = jnp.exp(w_log - m_loc[..., None])[..., None] * k
    c_loc = jnp.einsum('bhcld,bhcle->bhcde', wk, v)
    n_loc = jnp.sum(wk, axis=3)

    def step(carry, xs):
        c_st, n_st, m_st = carry
        bl, ml, cl, nl = xs
        m_new = jnp.maximum(bl + m_st, ml)
        a = jnp.exp(bl + m_st - m_new)
        e = jnp.exp(ml - m_new)
        c_new = a[..., None, None] * c_st + e[..., None, None] * cl
        n_new = a[..., None] * n_st + e[..., None] * nl
        return (c_new, n_new, m_new), (c_st, n_st, m_st)

    init = (jnp.zeros((bsz, nh, dk, dv), f32), jnp.zeros((bsz, nh, dk), f32), jnp.full((bsz, nh), NEG_INIT, f32))
    xs = (jnp.moveaxis(b_last, 2, 0), jnp.moveaxis(m_loc, 2, 0), jnp.moveaxis(c_loc, 2, 0), jnp.moveaxis(n_loc, 2, 0))
    _, (c_prev, n_prev, m_prev) = lax.scan(step, init, xs)
    c_prev = jnp.moveaxis(c_prev, 0, 2)
    n_prev = jnp.moveaxis(n_prev, 0, 2)
    m_prev = jnp.moveaxis(m_prev, 0, 2)
    causal = jnp.tril(jnp.ones((CHUNK, CHUNK), dtype=bool))
    d_log = jnp.where(causal, b[..., :, None] - b[..., None, :] + ig[..., None, :], -jnp.inf)
    inter_log = b + m_prev[..., None]
    m_t = jnp.maximum(inter_log, jnp.max(d_log, axis=-1))
    scores = jnp.einsum('bhctd,bhcsd->bhcts', q, k) * jnp.exp(d_log - m_t[..., None])
    inter_w = jnp.exp(inter_log - m_t)
    num = jnp.einsum('bhcts,bhcse->bhcte', scores, v) + inter_w[..., None] * jnp.einsum('bhctd,bhcde->bhcte', q, c_prev)
    den = jnp.sum(scores, axis=-1) + inter_w * jnp.einsum('bhctd,bhcd->bhct', q, n_prev)
    h = num / jnp.maximum(jnp.abs(den), jnp.exp(-m_t))[..., None]
    return h.reshape(bsz, nh, s, dv)


def hybrid_layer(x, cos, sin, layer_idx, norm_g, w_in, q_norm_g, k_norm_g, lambda_qk, attn_norm_g, w_out_a,
                 conv_w, conv_b, igate_b, fgate_b, mlstm_norm_g, w_out_b, w_o):
    bsz, s, _ = x.shape
    h = rmsnorm(x, norm_g)
    proj = h @ w_in
    idx = [int(i) for i in np.cumsum(SPLITS)[:-1]]
    aq, ak, av, az, bqk, bv, bi, bf, bo, bz, ga, gb = jnp.split(proj, idx, axis=-1)

    def two_map_heads(t):
        return t.reshape(bsz, s, A_HEADS, 2, A_HEAD_DIM).transpose(0, 2, 1, 3, 4)
    q = rope(rmsnorm(two_map_heads(aq), q_norm_g), cos, sin)
    k = rope(rmsnorm(two_map_heads(ak), k_norm_g), cos, sin)
    v = av.reshape(bsz, s, A_HEADS, A_V_DIM).transpose(0, 2, 1, 3)
    lam_init = 0.8 - 0.6 * math.exp(-0.3 * layer_idx)
    lq1, lk1, lq2, lk2 = lambda_qk[0], lambda_qk[1], lambda_qk[2], lambda_qk[3]
    lam = jnp.exp(jnp.sum(lq1 * lk1)) - jnp.exp(jnp.sum(lq2 * lk2)) + lam_init
    oa = diff_attention(q, k, v, lam)
    oa = rmsnorm(oa, attn_norm_g) * (1.0 - lam_init)
    oa = oa.transpose(0, 2, 1, 3).reshape(bsz, s, A_WIDTH) * jax.nn.silu(az)
    ya = oa @ w_out_a

    qk = jax.nn.silu(causal_conv(bqk, conv_w, conv_b))
    mq, mk = jnp.split(qk, 2, axis=-1)
    mq = mq.reshape(bsz, s, B_HEADS, B_QK_DIM).transpose(0, 2, 1, 3)
    mk = mk.reshape(bsz, s, B_HEADS, B_QK_DIM).transpose(0, 2, 1, 3)
    mv = bv.reshape(bsz, s, B_HEADS, B_V_DIM).transpose(0, 2, 1, 3)
    i_pre = (bi + igate_b).transpose(0, 2, 1)
    f_pre = (bf + fgate_b).transpose(0, 2, 1)
    hb = mlstm_chunkwise(mq, mk, mv, i_pre, f_pre).astype(x.dtype)
    hb = rmsnorm(hb, mlstm_norm_g).transpose(0, 2, 1, 3).reshape(bsz, s, B_WIDTH)
    hb = jax.nn.sigmoid(bo) * hb * jax.nn.silu(bz)
    yb = hb @ w_out_b

    u = jax.nn.sigmoid(ga) * ya + jax.nn.sigmoid(gb) * yb
    return x + u @ w_o


def setup_inputs(seed: int = 0) -> dict:
    key = jax.random.key(seed)
    ks = jax.random.split(key, 16)
    f32 = jnp.float32
    x = jax.random.normal(ks[0], (BATCH, SEQ, D_MODEL), f32)
    offsets = jax.random.randint(ks[1], (BATCH, 1), 0, 4096, dtype=jnp.int32)
    positions = (offsets + jnp.arange(SEQ, dtype=jnp.int32)[None, :]).astype(jnp.int32)
    norm_g = 1.0 + 0.02 * jax.random.normal(ks[2], (DEPTH, D_MODEL), f32)
    w_in = jax.random.normal(ks[3], (DEPTH, D_MODEL, D_IN), f32) * D_MODEL ** -0.5
    q_norm_g = 1.0 + 0.02 * jax.random.normal(ks[4], (DEPTH, A_HEAD_DIM), f32)
    k_norm_g = 1.0 + 0.02 * jax.random.normal(ks[5], (DEPTH, A_HEAD_DIM), f32)
    lambda_qk = 0.1 * jax.random.normal(ks[6], (DEPTH, 4, A_HEAD_DIM), f32)
    attn_norm_g = 1.0 + 0.02 * jax.random.normal(ks[7], (DEPTH, A_V_DIM), f32)
    w_out_a = jax.random.normal(ks[8], (DEPTH, A_WIDTH, D_MODEL), f32) * A_WIDTH ** -0.5
    conv_w = jax.random.normal(ks[9], (DEPTH, CONV_WIDTH, 2 * B_HEADS * B_QK_DIM), f32) * CONV_WIDTH ** -0.5
    conv_b = 0.02 * jax.random.normal(ks[10], (DEPTH, 2 * B_HEADS * B_QK_DIM), f32)
    igate_b = 0.1 * jax.random.normal(ks[11], (DEPTH, B_HEADS), f32)
    fgate_b = jnp.linspace(3.0, 6.0, B_HEADS, dtype=f32)[None, :] + 0.1 * jax.random.normal(ks[12], (DEPTH, B_HEADS), f32)
    mlstm_norm_g = 1.0 + 0.02 * jax.random.normal(ks[13], (DEPTH, B_V_DIM), f32)
    w_out_b = jax.random.normal(ks[14], (DEPTH, B_WIDTH, D_MODEL), f32) * B_WIDTH ** -0.5
    w_o = jax.random.normal(ks[15], (DEPTH, D_MODEL, D_MODEL), f32) * D_MODEL ** -0.5
    return {'x': x, 'positions': positions, 'norm_g': norm_g, 'w_in': w_in, 'q_norm_g': q_norm_g,
            'k_norm_g': k_norm_g, 'lambda_qk': lambda_qk, 'attn_norm_g': attn_norm_g, 'w_out_a': w_out_a,
            'conv_w': conv_w, 'conv_b': conv_b, 'igate_b': igate_b, 'fgate_b': fgate_b,
            'mlstm_norm_g': mlstm_norm_g, 'w_out_b': w_out_b, 'w_o': w_o}


def reference(x, positions, norm_g, w_in, q_norm_g, k_norm_g, lambda_qk, attn_norm_g, w_out_a,
              conv_w, conv_b, igate_b, fgate_b, mlstm_norm_g, w_out_b, w_o):
    inv_freq = ROPE_THETA ** (-jnp.arange(0, A_HEAD_DIM, 2, dtype=jnp.float32) / A_HEAD_DIM)
    ang = positions.astype(jnp.float32)[..., None] * inv_freq
    cos = jnp.cos(ang)[:, None, :, None, :]
    sin = jnp.sin(ang)[:, None, :, None, :]
    for l in range(DEPTH):
        x = hybrid_layer(x, cos, sin, l, norm_g[l], w_in[l], q_norm_g[l], k_norm_g[l], lambda_qk[l],
                         attn_norm_g[l], w_out_a[l], conv_w[l], conv_b[l], igate_b[l], fgate_b[l],
                         mlstm_norm_g[l], w_out_b[l], w_o[l])
    return x
```

```cpp
#include <hip/hip_runtime.h>
#include <cstdio>
#include <cstdint>
#include <cmath>
constexpr int NB = 4, SEQ = 8192, DM = 1024, NTOK = NB * SEQ, TH = NTOK / 2, NLAYER = 2, DIN = 10256;
constexpr int WT_ROWS = 10496;
constexpr int NCHUNK_H = 2 * 8 * 128;
constexpr int CST_STRIDE = 129 * 64;
constexpr float EPS = 1e-6f;
constexpr float QSCALE = 0.125f * 1.4426950408889634f;
constexpr size_t MiB = 1u << 20;
constexpr size_t WS_CTL = 0, WS_WTIN = 1 * MiB, WS_WTOA = 43 * MiB, WS_WTOB = 47 * MiB, WS_WTO = 51 * MiB, WS_COS = 55 * MiB, WS_SIN = 59 * MiB,
                 WS_H = 64 * MiB, WS_Q = 96 * MiB, WS_K = 128 * MiB, WS_SAZ = 160 * MiB, WS_BQK = 192 * MiB, WS_VT = 224 * MiB, WS_BOG = 288 * MiB,
                 WS_SGA = 320 * MiB, WS_SGB = 352 * MiB, WS_GATES = 384 * MiB, WS_MST = 385 * MiB, WS_CST = 386 * MiB, WS_END = 452 * MiB;
static_assert((size_t)WT_ROWS * 1024 * 2 * 2 <= WS_WTOA - WS_WTIN, "wt_in copies");
static_assert((size_t)NCHUNK_H * CST_STRIDE * 4 <= WS_END - WS_CST, "states");
namespace pg8 {
#define PG8_LAS __attribute__((address_space(3)))
typedef unsigned short bf16_t;
typedef short bf16x8 __attribute__((ext_vector_type(8)));
typedef float f32x4 __attribute__((ext_vector_type(4)));
typedef unsigned u32x4 __attribute__((ext_vector_type(4)));
constexpr int BM = 256, BK = 64, HALF = 128, HTB = HALF * BK * 2  , STAGE_BYTES = 8 * HTB, NXCD = 8, WGM = 8;

__host__ __device__ __forceinline__ int lds_byte(int r, int c) { const int st = (r >> 4) * 2 + (c >> 5), rr = r & 15, cc = c & 31, ob = rr * 64 + cc * 2; return st * 1024 + (ob ^ (((ob >> 9) & 1) << 5)); }
__host__ __device__ __forceinline__ void stage_rc(int b, int& R, int& C) { const int st = b / 1024, sb = b % 1024, swz = sb ^ (((sb >> 9) & 1) << 5); R = (st >> 1) * 16 + swz / 64; C = (st & 1) * 32 + (swz % 64) / 2; }
__host__ __device__ __forceinline__ int perm32(int rho) { const int n = rho >> 4, i = rho & 15; return 8 * (i >> 2) + 4 * n + (i & 3); }

struct Unit { int pm, pn; };
struct Gemm { const bf16_t* A; const bf16_t* Bt; int M, N, K; };

struct StaticOrder {
    int nM, nN, nwg, G, c;
    __host__ __device__ void init(int M, int N, int G_, int c_) { nM = M / BM; nN = N / BM; nwg = nM * nN; G = G_; c = c_; }
    __host__ __device__ bool next(int i, Unit& u) const {
        const long L = (long)i * G + c; if (L >= nwg) return false;
        int wgid = (int)L; { const int q = nwg / NXCD, r = nwg % NXCD, xcd = wgid % NXCD, off = wgid / NXCD; wgid = (xcd < r ? xcd * (q + 1) : r * (q + 1) + (xcd - r) * q) + off; }
        const int nig = WGM * nN, gid = wgid / nig, fm = gid * WGM, gsz = (nM - fm) < WGM ? (nM - fm) : WGM;
        u.pm = fm + ((wgid % nig) % gsz); u.pn = (wgid % nig) / gsz; return true;
    }
    __device__ __forceinline__ void a_ready(const Unit&) const {}
    __device__ __forceinline__ void done(const Unit&) const {}
};

typedef float f32x2c_t __attribute__((ext_vector_type(2))); typedef __bf16 bf16x2c_t __attribute__((ext_vector_type(2)));
__device__ __forceinline__ unsigned cvt_pk_bf16(float lo, float hi) { f32x2c_t v = {lo, hi}; bf16x2c_t b = __builtin_convertvector(v, bf16x2c_t); return __builtin_bit_cast(unsigned, b); }
typedef float f32x2 __attribute__((ext_vector_type(2)));
typedef unsigned u32x4e __attribute__((ext_vector_type(4)));
__device__ __forceinline__ float sigm(float x) { return __builtin_amdgcn_rcpf(1.0f + __expf(-x)); }
__device__ __forceinline__ u32x4e pack8(const f32x4& a, const f32x4& b) { u32x4e w; w.x = cvt_pk_bf16(a[0], a[1]); w.y = cvt_pk_bf16(a[2], a[3]); w.z = cvt_pk_bf16(b[0], b[1]); w.w = cvt_pk_bf16(b[2], b[3]); return w; }
__device__ __forceinline__ float bf_lo(unsigned w) { return __uint_as_float(w << 16); }
__device__ __forceinline__ float bf_hi(unsigned w) { return __uint_as_float(w & 0xffff0000u); }
__device__ __forceinline__ void unpack8(const u32x4e w, f32x4& a, f32x4& b) { a[0] = bf_lo(w.x); a[1] = bf_hi(w.x); a[2] = bf_lo(w.y); a[3] = bf_hi(w.y); b[0] = bf_lo(w.z); b[1] = bf_hi(w.z); b[2] = bf_lo(w.w); b[3] = bf_hi(w.w); }

struct EpiPlain {
    static constexpr bool PERM = true, AFTER_DRAIN = false;
    bf16_t* O; int ldc;
    __device__ __forceinline__ void operator()(const f32x4 (&acc)[2][2][4][2], const Unit& u, int wr, int wc, int fr, int fq) const {
        const int row0 = u.pm * BM + wr * 64 + fr, col0 = u.pn * BM + wc * 32 + 8 * fq;
#pragma unroll
        for (int ai = 0; ai < 2; ++ai)
#pragma unroll
            for (int m = 0; m < 4; ++m) { bf16_t* rowp = O + (size_t)(row0 + ai * HALF + m * 16) * ldc + col0;
#pragma unroll
                for (int bj = 0; bj < 2; ++bj) *(u32x4e*)(rowp + bj * HALF) = pack8(acc[ai][bj][m][0], acc[ai][bj][m][1]); }
    }
};

struct EpiMain {
    static constexpr bool PERM = true, AFTER_DRAIN = false;
    unsigned char* ws;
    const float *qg, *kg;
    const float *cosT, *sinT;
    float qscale;
    __device__ __forceinline__ void operator()(const f32x4 (&acc)[2][2][4][2], const Unit& u, int wr, int wc, int fr, int fq) const {
        const int pn = u.pn; const int row0 = u.pm * BM + wr * 64 + fr; const int x0 = wc * 32 + 8 * fq;
        if (pn < 8) {
            bf16_t* O = (bf16_t*)(ws + (pn < 4 ? WS_Q : WS_K)); const float* g = pn < 4 ? qg : kg; const float sc = pn < 4 ? qscale : 1.0f;
            const int gcol = (pn & 3) * 256 + wc * 64, j0 = 8 * fq;
#pragma unroll
            for (int ai = 0; ai < 2; ++ai)
#pragma unroll
                for (int m = 0; m < 4; ++m) {
                    const int row = row0 + ai * HALF + m * 16;
                    float ss = 0.f;
#pragma unroll
                    for (int bj = 0; bj < 2; ++bj)
#pragma unroll
                        for (int n = 0; n < 2; ++n) { const f32x4 v = acc[ai][bj][m][n]; ss += (v[0] * v[0] + v[1] * v[1]) + (v[2] * v[2] + v[3] * v[3]); }
                    ss += __shfl_xor(ss, 16); ss += __shfl_xor(ss, 32);
                    const float rs = rsqrtf(ss * (1.0f / 64.0f) + 1e-6f);
                    bf16_t* rowp = O + (size_t)row * 1024 + gcol + j0;
                    u32x4e w1, w2;
#pragma unroll
                    for (int n = 0; n < 2; ++n) {
                        const f32x4 cc = *(const f32x4*)(cosT + (size_t)row * 32 + j0 + 4 * n), sn = *(const f32x4*)(sinT + (size_t)row * 32 + j0 + 4 * n);
                        const f32x4 ga = *(const f32x4*)(g + j0 + 4 * n), gb = *(const f32x4*)(g + 32 + j0 + 4 * n);
                        const f32x4 a = acc[ai][0][m][n] * rs * ga, b = acc[ai][1][m][n] * rs * gb;
                        const f32x4 o1 = (a * cc - b * sn) * sc, o2 = (b * cc + a * sn) * sc;
                        if (n == 0) { w1.x = cvt_pk_bf16(o1[0], o1[1]); w1.y = cvt_pk_bf16(o1[2], o1[3]); w2.x = cvt_pk_bf16(o2[0], o2[1]); w2.y = cvt_pk_bf16(o2[2], o2[3]); }
                        else        { w1.z = cvt_pk_bf16(o1[0], o1[1]); w1.w = cvt_pk_bf16(o1[2], o1[3]); w2.z = cvt_pk_bf16(o2[0], o2[1]); w2.w = cvt_pk_bf16(o2[2], o2[3]); }
                    }
                    *(u32x4e*)(rowp) = w1;
                    *(u32x4e*)(rowp + 32) = w2;
                    if (m == 3) asm volatile("" ::: "memory");
                }
        } else if (pn < 16) {
            bf16_t* O = (bf16_t*)(ws + (pn < 12 ? WS_SAZ : WS_BQK)); const bool act = pn < 12; const int colt = (pn & 3) * 256 + x0;
#pragma unroll
            for (int ai = 0; ai < 2; ++ai)
#pragma unroll
                for (int m = 0; m < 4; ++m) { bf16_t* rowp = O + (size_t)(row0 + ai * HALF + m * 16) * 1024 + colt;
#pragma unroll
                    for (int bj = 0; bj < 2; ++bj) { f32x4 v0 = acc[ai][bj][m][0], v1 = acc[ai][bj][m][1];
                        if (act) {
#pragma unroll
                            for (int e = 0; e < 4; ++e) { v0[e] = v0[e] * sigm(v0[e]); v1[e] = v1[e] * sigm(v1[e]); } }
                        *(u32x4e*)(rowp + bj * HALF) = pack8(v0, v1); } }
        } else if (pn < 24) {
            const int colt = (pn - 16) * 128 + x0;
#pragma unroll
            for (int ai = 0; ai < 2; ++ai)
#pragma unroll
                for (int m = 0; m < 4; ++m) { bf16_t* rowp = (bf16_t*)(ws + WS_BOG) + (size_t)(row0 + ai * HALF + m * 16) * 1024 + colt;
                    f32x4 v0, v1;
#pragma unroll
                    for (int e = 0; e < 4; ++e) { const float o0 = acc[ai][0][m][0][e], z0 = acc[ai][1][m][0][e], o1 = acc[ai][0][m][1][e], z1 = acc[ai][1][m][1][e];
                        v0[e] = sigm(o0) * z0 * sigm(z0); v1[e] = sigm(o1) * z1 * sigm(z1); }
                    *(u32x4e*)(rowp) = pack8(v0, v1); }
        } else if (pn < 32) {
            bf16_t* O = (bf16_t*)(ws + (pn < 28 ? WS_SGA : WS_SGB)); const int colt = (pn & 3) * 256 + x0;
#pragma unroll
            for (int ai = 0; ai < 2; ++ai)
#pragma unroll
                for (int m = 0; m < 4; ++m) { bf16_t* rowp = O + (size_t)(row0 + ai * HALF + m * 16) * 1024 + colt;
#pragma unroll
                    for (int bj = 0; bj < 2; ++bj) { f32x4 v0 = acc[ai][bj][m][0], v1 = acc[ai][bj][m][1];
#pragma unroll
                        for (int e = 0; e < 4; ++e) { v0[e] = sigm(v0[e]); v1[e] = sigm(v1[e]); }
                        *(u32x4e*)(rowp + bj * HALF) = pack8(v0, v1); } }
        } else {
            if (wc == 0 && fq < 2) {
#pragma unroll
                for (int ai = 0; ai < 2; ++ai)
#pragma unroll
                    for (int m = 0; m < 4; ++m) { float* rowp = (float*)(ws + WS_GATES) + (size_t)(row0 + ai * HALF + m * 16) * 16 + 8 * fq;
                        *(f32x4*)(rowp) = acc[ai][0][m][0]; *(f32x4*)(rowp + 4) = acc[ai][0][m][1]; }
            }
        }
    }
};

struct EpiOutA {
    static constexpr bool PERM = true, AFTER_DRAIN = false;
    bf16_t* U; const bf16_t* G;
    __device__ __forceinline__ void operator()(const f32x4 (&acc)[2][2][4][2], const Unit& u, int wr, int wc, int fr, int fq) const {
        const int row0 = u.pm * BM + wr * 64 + fr, col0 = u.pn * BM + wc * 32 + 8 * fq;
#pragma unroll
        for (int ai = 0; ai < 2; ++ai)
#pragma unroll
            for (int m = 0; m < 4; ++m) { const size_t off = (size_t)(row0 + ai * HALF + m * 16) * 1024 + col0;
#pragma unroll
                for (int bj = 0; bj < 2; ++bj) { f32x4 g0, g1; unpack8(*(const u32x4e*)(G + off + bj * HALF), g0, g1);
                    *(u32x4e*)(U + off + bj * HALF) = pack8(acc[ai][bj][m][0] * g0, acc[ai][bj][m][1] * g1); } asm volatile("" ::: "memory"); }
    }
};
struct EpiOutB {
    static constexpr bool PERM = true, AFTER_DRAIN = false;
    bf16_t* U; const bf16_t* G;
    __device__ __forceinline__ void operator()(const f32x4 (&acc)[2][2][4][2], const Unit& u, int wr, int wc, int fr, int fq) const {
        const int row0 = u.pm * BM + wr * 64 + fr, col0 = u.pn * BM + wc * 32 + 8 * fq;
#pragma unroll
        for (int ai = 0; ai < 2; ++ai)
#pragma unroll
            for (int m = 0; m < 4; ++m) { const size_t off = (size_t)(row0 + ai * HALF + m * 16) * 1024 + col0;
#pragma unroll
                for (int bj = 0; bj < 2; ++bj) { f32x4 g0, g1, p0, p1; unpack8(*(const u32x4e*)(G + off + bj * HALF), g0, g1); unpack8(*(const u32x4e*)(U + off + bj * HALF), p0, p1);
                    *(u32x4e*)(U + off + bj * HALF) = pack8(p0 + acc[ai][bj][m][0] * g0, p1 + acc[ai][bj][m][1] * g1); } asm volatile("" ::: "memory"); }
    }
};
struct EpiFinal {
    static constexpr bool PERM = true, AFTER_DRAIN = false;
    const float* base; float* out;
    __device__ __forceinline__ void operator()(const f32x4 (&acc)[2][2][4][2], const Unit& u, int wr, int wc, int fr, int fq) const {
        const int row0 = u.pm * BM + wr * 64 + fr, col0 = u.pn * BM + wc * 32 + 8 * fq;
#pragma unroll
        for (int ai = 0; ai < 2; ++ai)
#pragma unroll
            for (int m = 0; m < 4; ++m) { const size_t off = (size_t)(row0 + ai * HALF + m * 16) * 1024 + col0;
#pragma unroll
                for (int bj = 0; bj < 2; ++bj) { const f32x4 b0 = *(const f32x4*)(base + off + bj * HALF), b1 = *(const f32x4*)(base + off + bj * HALF + 4);
                    *(f32x4*)(out + off + bj * HALF) = b0 + acc[ai][bj][m][0]; *(f32x4*)(out + off + bj * HALF + 4) = b1 + acc[ai][bj][m][1]; } asm volatile("" ::: "memory"); }
    }
};

template <class Epi, class Sched, bool ALIGN_EPI = false, bool SP2 = false>
__device__ __forceinline__ void gemm_phase(PG8_LAS unsigned char* lds, const Gemm g, const Sched& S, const Epi& E) {
    int tid_l = threadIdx.x; asm volatile("" : "+v"(tid_l));
    const int tid = tid_l, wid = __builtin_amdgcn_readfirstlane(tid >> 6), lane = tid & 63, wr = wid >> 2, wc = wid & 3, fr = lane & 15, fq = lane >> 4;
    const int K = g.K, nt = K / BK;
    unsigned voffA[2], voffB[2];
#pragma unroll
    for (int i = 0; i < 2; ++i) { int R, C; stage_rc(tid * 16 + i * 8192, R, C); const int Rb = Epi::PERM ? ((R & ~31) + perm32(R & 31)) : R;
        voffA[i] = (unsigned)(R * K + C) * 2u; voffB[i] = (unsigned)(Rb * K + C) * 2u; }
    const size_t kstep = (size_t)(BK * 2);
    const size_t hstep = (size_t)HALF * K * 2;
    const size_t tstep = 2 * hstep;
    const unsigned ldsw = (unsigned)wid * 1024u;
    const int aoff = lds_byte(wr * 64 + fr, fq * 8), boff = lds_byte(wc * 32 + fr, fq * 8);
#define PG8_SA(b, h) (((b) * 2 + (h)) * HTB)
#define PG8_SB(b, h) ((4 + (b) * 2 + (h)) * HTB)
#define PG8_STAGE(bufoff, gbase, voff) do { _Pragma("unroll") for (int _i = 0; _i < 2; ++_i) \
        __builtin_amdgcn_global_load_lds((const unsigned*)((const char*)(gbase) + (voff)[_i]), (PG8_LAS unsigned*)(lds + (bufoff) + ldsw + _i * 8192), 16, 0, 0); } while (0)
#define PG8_LDA(dst, b, h) do { _Pragma("unroll") for (int m = 0; m < 4; ++m) _Pragma("unroll") for (int k = 0; k < 2; ++k) dst[m][k] = *(const PG8_LAS bf16x8*)(lds + PG8_SA(b, h) + aoff + m * 2048 + k * 1024); } while (0)
#define PG8_LDB(dst, b, h) do { _Pragma("unroll") for (int n = 0; n < 2; ++n) _Pragma("unroll") for (int k = 0; k < 2; ++k) dst[n][k] = *(const PG8_LAS bf16x8*)(lds + PG8_SB(b, h) + boff + n * 2048 + k * 1024); } while (0)
#define PG8_MMA(ai, bj, At, Bt) do { __builtin_amdgcn_s_setprio(1); _Pragma("unroll") for (int m = 0; m < 4; ++m) _Pragma("unroll") for (int n = 0; n < 2; ++n) _Pragma("unroll") for (int k = 0; k < 2; ++k) \
        acc[ai][bj][m][n] = __builtin_amdgcn_mfma_f32_16x16x32_bf16(Bt[n][k], At[m][k], acc[ai][bj][m][n], 0, 0, 0); __builtin_amdgcn_s_setprio(0); } while (0)
#define PG8_WAIT_V(n) asm volatile("s_waitcnt vmcnt(" #n ")" ::: "memory")
#define PG8_WAIT_L(n) asm volatile("s_waitcnt lgkmcnt(" #n ")" ::: "memory")
#define PG8_BAR __builtin_amdgcn_s_barrier()
#define PG8_SCHED __builtin_amdgcn_sched_barrier(0)
    Unit cur, nxt; int ui = 0;
    if (!S.next(0, cur)) return;
    f32x4 acc[2][2][4][2];
#pragma unroll
    for (int a = 0; a < 2; ++a)
#pragma unroll
        for (int b = 0; b < 2; ++b)
#pragma unroll
            for (int m = 0; m < 4; ++m)
#pragma unroll
                for (int n = 0; n < 2; ++n) acc[a][b][m][n] = (f32x4){0.f, 0.f, 0.f, 0.f};
    bf16x8 At[4][2], B0[2][2], B1[2][2];
    const char* cA = (const char*)g.A + (size_t)cur.pm * tstep; const char* cB = (const char*)g.Bt + (size_t)cur.pn * tstep;
    S.a_ready(cur);
    if constexpr (SP2) {
        PG8_STAGE(PG8_SB(0, 0), cB, voffB); PG8_STAGE(PG8_SB(0, 1), cB + hstep, voffB); PG8_STAGE(PG8_SA(0, 0), cA, voffA); PG8_STAGE(PG8_SA(0, 1), cA + hstep, voffA);
        if (wr == 1) PG8_BAR;
        PG8_WAIT_V(2); PG8_BAR;
        PG8_STAGE(PG8_SB(1, 0), cB + kstep, voffB); PG8_STAGE(PG8_SA(1, 0), cA + kstep, voffA); PG8_STAGE(PG8_SB(1, 1), cB + hstep + kstep, voffB);
        PG8_WAIT_V(6); PG8_BAR;
    } else {
        PG8_STAGE(PG8_SB(0, 0), cB, voffB); PG8_STAGE(PG8_SA(0, 0), cA, voffA); PG8_STAGE(PG8_SB(0, 1), cB + hstep, voffB); PG8_STAGE(PG8_SA(0, 1), cA + hstep, voffA);
        if (wr == 1) PG8_BAR;
        PG8_WAIT_V(4); PG8_BAR;
        PG8_STAGE(PG8_SB(1, 0), cB + kstep, voffB); PG8_STAGE(PG8_SA(1, 0), cA + kstep, voffA); PG8_STAGE(PG8_SB(1, 1), cB + hstep + kstep, voffB);
        PG8_WAIT_V(6); PG8_BAR;
    }
    for (;;) {
        const bool has_next = S.next(ui + 1, nxt);
        const char* nA = has_next ? (const char*)g.A + (size_t)nxt.pm * tstep : cA; const char* nB = has_next ? (const char*)g.Bt + (size_t)nxt.pn * tstep : cB;
        for (int t = 0; t < nt; t += 2) {
            const bool last = (t == nt - 2);
            const char* a1 = cA + (size_t)(t + 1) * kstep;
            const char* a2 = last ? nA : cA + (size_t)(t + 2) * kstep; const char* b2 = last ? nB : cB + (size_t)(t + 2) * kstep;
            const char* a3 = a2 + kstep; const char* b3 = b2 + kstep;
            if (last && has_next) S.a_ready(nxt);
            if constexpr (SP2) {
            PG8_LDB(B0, 0, 0); PG8_LDB(B1, 0, 1); PG8_SCHED; PG8_LDA(At, 0, 0); PG8_STAGE(PG8_SA(1, 1), a1 + hstep, voffA);
            PG8_WAIT_V(8); PG8_WAIT_L(0); PG8_BAR; PG8_MMA(0, 0, At, B0); PG8_MMA(0, 1, At, B1); PG8_BAR; PG8_SCHED;
            PG8_LDA(At, 0, 1); PG8_STAGE(PG8_SB(0, 0), b2, voffB); PG8_STAGE(PG8_SB(0, 1), b2 + hstep, voffB); PG8_STAGE(PG8_SA(0, 0), a2, voffA);
            PG8_WAIT_V(8); PG8_WAIT_L(0); PG8_BAR; PG8_MMA(1, 0, At, B0); PG8_MMA(1, 1, At, B1); PG8_BAR; PG8_SCHED;
            PG8_LDB(B0, 1, 0); PG8_LDB(B1, 1, 1); PG8_SCHED; PG8_LDA(At, 1, 0); PG8_STAGE(PG8_SA(0, 1), a2 + hstep, voffA);
            PG8_WAIT_V(8); PG8_WAIT_L(0); PG8_BAR; PG8_MMA(0, 0, At, B0); PG8_MMA(0, 1, At, B1); PG8_BAR; PG8_SCHED;
            PG8_LDA(At, 1, 1); PG8_STAGE(PG8_SB(1, 0), b3, voffB); PG8_STAGE(PG8_SB(1, 1), b3 + hstep, voffB); PG8_STAGE(PG8_SA(1, 0), a3, voffA);
            PG8_WAIT_V(8); PG8_WAIT_L(0); PG8_BAR; PG8_MMA(1, 0, At, B0); PG8_MMA(1, 1, At, B1); PG8_BAR; PG8_SCHED;
            } else {
            PG8_LDB(B0, 0, 0); PG8_SCHED; PG8_LDA(At, 0, 0); PG8_STAGE(PG8_SA(1, 1), a1 + hstep, voffA);
            PG8_WAIT_L(8); PG8_BAR; PG8_WAIT_L(0); PG8_MMA(0, 0, At, B0); PG8_BAR; PG8_SCHED;
            PG8_LDB(B1, 0, 1); PG8_STAGE(PG8_SB(0, 0), b2, voffB);
            PG8_BAR; PG8_WAIT_L(0); PG8_MMA(0, 1, At, B1); PG8_BAR;
            PG8_LDA(At, 0, 1); PG8_STAGE(PG8_SA(0, 0), a2, voffA);
            PG8_BAR; PG8_WAIT_L(0); PG8_MMA(1, 0, At, B0); PG8_BAR; PG8_SCHED;
            PG8_STAGE(PG8_SB(0, 1), b2 + hstep, voffB);
            PG8_WAIT_V(6); PG8_BAR; PG8_MMA(1, 1, At, B1); PG8_BAR;
            PG8_LDB(B0, 1, 0); PG8_SCHED; PG8_LDA(At, 1, 0); PG8_STAGE(PG8_SA(0, 1), a2 + hstep, voffA);
            PG8_WAIT_L(8); PG8_BAR; PG8_WAIT_L(0); PG8_MMA(0, 0, At, B0); PG8_BAR; PG8_SCHED;
            PG8_LDB(B1, 1, 1); PG8_STAGE(PG8_SB(1, 0), b3, voffB);
            PG8_BAR; PG8_WAIT_L(0); PG8_MMA(0, 1, At, B1); PG8_BAR;
            PG8_LDA(At, 1, 1); PG8_STAGE(PG8_SA(1, 0), a3, voffA);
            PG8_BAR; PG8_WAIT_L(0); PG8_MMA(1, 0, At, B0); PG8_BAR; PG8_SCHED;
            PG8_STAGE(PG8_SB(1, 1), b3 + hstep, voffB);
            PG8_WAIT_V(6); PG8_BAR; PG8_MMA(1, 1, At, B1); PG8_BAR;
            }
        }
        if constexpr (ALIGN_EPI) { if (wr == 0) PG8_BAR; }
        if constexpr (!Epi::AFTER_DRAIN) { E(acc, cur, wr, wc, fr, fq); S.done(cur); }
        if (!has_next) break;
#pragma unroll
        for (int a = 0; a < 2; ++a)
#pragma unroll
            for (int b = 0; b < 2; ++b)
#pragma unroll
                for (int m = 0; m < 4; ++m)
#pragma unroll
                    for (int n = 0; n < 2; ++n) acc[a][b][m][n] = (f32x4){0.f, 0.f, 0.f, 0.f};
        cur = nxt; cA = nA; cB = nB; ++ui;
        if constexpr (ALIGN_EPI) { if (wr == 1) PG8_BAR; }
    }
    PG8_WAIT_V(0);
    if constexpr (!ALIGN_EPI) { if (wr == 0) PG8_BAR; }
    PG8_BAR;
    if constexpr (Epi::AFTER_DRAIN) { E.fused(acc, cur, wr, wc, fr, fq, lds, wid, lane); S.done(cur); }
#undef PG8_SA
#undef PG8_SB
#undef PG8_STAGE
#undef PG8_LDA
#undef PG8_LDB
#undef PG8_MMA
#undef PG8_WAIT_V
#undef PG8_WAIT_L
#undef PG8_BAR
#undef PG8_SCHED
}
}
#include <hip/hip_cooperative_groups.h>
namespace cg = cooperative_groups;
#define LAS __attribute__((address_space(3)))
typedef unsigned short bf16;
typedef float f32x4 __attribute__((ext_vector_type(4)));
typedef float f32x16 __attribute__((ext_vector_type(16)));
typedef short bf16x8 __attribute__((ext_vector_type(8)));
typedef unsigned u32x4 __attribute__((ext_vector_type(4)));
typedef unsigned u32x2 __attribute__((ext_vector_type(2)));

constexpr int LDS_BYTES = 147456;

struct Params {
    const float* in[16]; float* out; unsigned char* ws; float inv_freq[32]; float lam_init[2]; int pad[2];
};

__device__ __forceinline__ unsigned f2bf(float f) { unsigned u = __builtin_bit_cast(unsigned, f); return (u + 0x7fffu + ((u >> 16) & 1u)) >> 16; }
__device__ __forceinline__ unsigned pk2(float lo, float hi) { return pg8::cvt_pk_bf16(lo, hi); }
__device__ __forceinline__ float bflo(unsigned w) { return __uint_as_float(w << 16); }
__device__ __forceinline__ float bfhi(unsigned w) { return __uint_as_float(w & 0xffff0000u); }
__device__ __forceinline__ float wave_sum(float v) {
    int l = (int)__builtin_amdgcn_mbcnt_hi(~0u, __builtin_amdgcn_mbcnt_lo(~0u, 0u)); asm volatile("" : "+v"(l));
#pragma unroll
    for (int o = 1; o < 64; o <<= 1) v += __uint_as_float((unsigned)__builtin_amdgcn_ds_bpermute((l ^ o) << 2, (int)__float_as_uint(v)));
    return v;
}
__device__ __forceinline__ float wave_max(float v) {
    int l = (int)__builtin_amdgcn_mbcnt_hi(~0u, __builtin_amdgcn_mbcnt_lo(~0u, 0u)); asm volatile("" : "+v"(l));
#pragma unroll
    for (int o = 1; o < 64; o <<= 1) v = fmaxf(v, __uint_as_float((unsigned)__builtin_amdgcn_ds_bpermute((l ^ o) << 2, (int)__float_as_uint(v))));
    return v;
}
__device__ __forceinline__ float sigm(float x) { return __builtin_amdgcn_rcpf(1.0f + __expf(-x)); }

typedef const __attribute__((address_space(4))) Params* KParams;
__device__ __forceinline__ int win_logical(int pb, int& valid) {
    const int p = pb * 32; valid = 32;
    if (p < 2048) { const int sec = p >> 10, pp = p & 1023, tile = pp >> 8, x = pp & 255, bj = x >> 7, wc = (x & 127) >> 5; return sec * 1024 + tile * 256 + 64 * wc + 32 * bj; }
    if (p < 3072) return 3072 + (p - 2048);
    if (p < 4096) return 4096 + (p - 3072);
    if (p < 6144) { const int pp = p - 4096, j = pp >> 8, x = pp & 255, bj = x >> 7, xx = x & 127; return (bj == 0 ? 6160 : 7184) + 128 * j + xx; }
    if (p < 7168) return 8208 + (p - 6144);
    if (p < 8192) return 9232 + (p - 7168);
    if (p < 8448) { if (p == 8192) { valid = 16; return 6144; } valid = 0; return 0; }
    if (p < 9472) return 2048 + (p - 8448);
    return 5120 + (p - 9472);
}
__device__ __forceinline__ void transpose_item(const float* W, int N, int lc, int valid, bf16* WT, int prow0, int k0, LAS float* scr, int lane) {
#pragma unroll 8
    for (int i = 0; i < 32; ++i) { const int kk = 2 * i + (lane >> 5), c = lane & 31; scr[kk * 33 + c] = (c < valid) ? W[(size_t)(k0 + kk) * N + lc + c] : 0.f; }
    asm volatile("s_waitcnt lgkmcnt(0)" ::: "memory");
    const int c = lane & 7;
#pragma unroll
    for (int j = 0; j < 4; ++j) { const int n = (lane >> 3) + 8 * j; const LAS float* s = scr + (8 * c) * 33 + n;
        u32x4 o; o.x = pk2(s[0 * 33], s[1 * 33]); o.y = pk2(s[2 * 33], s[3 * 33]); o.z = pk2(s[4 * 33], s[5 * 33]); o.w = pk2(s[6 * 33], s[7 * 33]);
        *(u32x4*)(WT + (size_t)(prow0 + n) * 1024 + k0 + 8 * c) = o; }
    asm volatile("s_waitcnt lgkmcnt(0)" ::: "memory");
}
__device__ __forceinline__ void sincos_d(double r, double& s, double& c) {
    const double r2 = r * r; double ss = 1.0, cc = 1.0;
#pragma unroll
    for (int n = 14; n >= 1; --n) { ss = 1.0 - ss * r2 * (1.0 / (double)((2 * n) * (2 * n + 1))); cc = 1.0 - cc * r2 * (1.0 / (double)((2 * n - 1) * (2 * n))); }
    s = r * ss; c = cc;
}
__device__ __forceinline__ void prologue(KParams P, LAS unsigned char* lds, int wave, int lane) {
    LAS float* scr = (LAS float*)(lds + wave * 16384);
    const int gw = blockIdx.x * 8 + wave, NGW = gridDim.x * 8;
    constexpr int PB = WT_ROWS / 32, I_IN = PB * 16, I_SQ = 32 * 16;
    constexpr int NITEMS = NLAYER * (I_IN + 3 * I_SQ);
    for (int it = gw; it < NITEMS; it += NGW) {
        const int l = it / (I_IN + 3 * I_SQ); int r = it % (I_IN + 3 * I_SQ);
        if (r < I_IN) { const int pb = r >> 4, kb = r & 15; int valid; const int lc = win_logical(pb, valid);
            transpose_item(P->in[3] + (size_t)l * 1024 * DIN, DIN, lc, valid, (bf16*)(P->ws + WS_WTIN) + (size_t)l * WT_ROWS * 1024, pb * 32, kb * 64, scr, lane); continue; }
        r -= I_IN; const int which = r / I_SQ; r %= I_SQ; const int pb = r >> 4, kb = r & 15;
        const float* W = (which == 0 ? P->in[8] : which == 1 ? P->in[14] : P->in[15]) + (size_t)l * 1024 * 1024;
        bf16* WT = (bf16*)(P->ws + (which == 0 ? WS_WTOA : which == 1 ? WS_WTOB : WS_WTO)) + (size_t)l * 1024 * 1024;
        transpose_item(W, 1024, pb * 32, 32, WT, pb * 32, kb * 64, scr, lane);
    }
    const int* pos = (const int*)P->in[1]; float* cosT = (float*)(P->ws + WS_COS); float* sinT = (float*)(P->ws + WS_SIN);
    int t_l = threadIdx.x; asm volatile("" : "+v"(t_l)); const int gt = blockIdx.x * 512 + t_l, NT = gridDim.x * 512;
    for (int i = gt; i < NTOK * 32; i += NT) {
        const float ang = (float)pos[i >> 5] * P->inv_freq[i & 31];
        const double a = (double)ang; const double k = __builtin_rint(a * 0.15915494309189535); const double r = a - k * 6.283185307179586476925;
        double s, c; sincos_d(r, s, c); cosT[i] = (float)c; sinT[i] = (float)s;
    }
}
__device__ __forceinline__ void rmsnorm_phase(const float* xin, const float* g, bf16* H, int wave, int lane) {
    asm volatile("" : "+v"(lane));
    const int gw = blockIdx.x * 8 + wave, NGW = gridDim.x * 8;
    f32x4 gv[4];
#pragma unroll
    for (int j = 0; j < 4; ++j) gv[j] = *((const f32x4*)g + lane + 64 * j);
    for (int m = gw; m < TH; m += NGW) {
        const f32x4* xr = (const f32x4*)(xin + (size_t)m * DM) + lane; f32x4 v[4]; float s = 0.f;
#pragma unroll
        for (int j = 0; j < 4; ++j) { v[j] = xr[64 * j]; s += (v[j].x * v[j].x + v[j].y * v[j].y) + (v[j].z * v[j].z + v[j].w * v[j].w); }
        const float rs = rsqrtf(wave_sum(s) * (1.0f / DM) + EPS);
        u32x2* o8 = (u32x2*)(H + (size_t)m * DM) + lane;
#pragma unroll
        for (int j = 0; j < 4; ++j) { u32x2 w; w.x = pk2(v[j].x * rs * gv[j].x, v[j].y * rs * gv[j].y); w.y = pk2(v[j].z * rs * gv[j].z, v[j].w * rs * gv[j].w); o8[64 * j] = w; }
    }
}

__device__ __forceinline__ void gates_phase(const bf16* H, const bf16* WTg, float* GATES) {
    int t_l = threadIdx.x; asm volatile("" : "+v"(t_l));
    const int lane = t_l & 63, fr = lane & 15, fq = lane >> 4, gw = blockIdx.x * 8 + (t_l >> 6), NGW = gridDim.x * 8;
    for (int task = gw; task < TH / 16; task += NGW) {
        const bf16* ap = H + (size_t)(task * 16 + fr) * 1024 + 8 * fq; const bf16* bp = WTg + (size_t)fr * 1024 + 8 * fq;
        f32x4 acc = {0.f, 0.f, 0.f, 0.f};
#pragma unroll 8
        for (int k0 = 0; k0 < 1024; k0 += 32) acc = __builtin_amdgcn_mfma_f32_16x16x32_bf16(*(const bf16x8*)(ap + k0), *(const bf16x8*)(bp + k0), acc, 0, 0, 0);
#pragma unroll
        for (int i = 0; i < 4; ++i) GATES[(size_t)(task * 16 + 4 * fq + i) * 16 + fr] = acc[i];
    }
}
constexpr int AK_STRIDE = 72, AV_STRIDE = 72;
constexpr int AK_BYTES = 64 * AK_STRIDE * 2, AV_BYTES = 128 * AV_STRIDE * 2;
__device__ __forceinline__ int crow(int r, int hi) { return (r & 3) + 8 * (r >> 2) + 4 * hi; }
#define ATT_BAR() do { asm volatile("s_waitcnt lgkmcnt(0)" ::: "memory"); __builtin_amdgcn_s_barrier(); asm volatile("" ::: "memory"); } while (0)
__device__ __forceinline__ void attn_unit(LAS unsigned char* lds, const bf16* Q, bf16* Oo, const bf16* K, const bf16* VT, const bf16* SAZ, const float* ang, float lam, float outscale, float negshift, int bl, int h, int qb) {
    int tid_l = threadIdx.x; asm volatile("" : "+v"(tid_l));
    const int tid = tid_l, lane = tid & 63, r32 = lane & 31, hi = lane >> 5; const int wid = __builtin_amdgcn_readfirstlane(tid >> 6);
    const size_t tok0 = (size_t)bl * SEQ; const int q0 = qb * 256 + wid * 32;
    LAS bf16* Ks = (LAS bf16*)lds; LAS bf16* Vs = (LAS bf16*)(lds + 2 * AK_BYTES);
    const int NT = 4 * (qb + 1);
    const LAS bf16* ksl = Ks + r32 * AK_STRIDE + hi * 8; const LAS bf16* vsl = Vs + r32 * AV_STRIDE + hi * 8;
    LAS unsigned* o0s = (LAS unsigned*)(lds + 57344) + wid * 2048 + lane;
    const int krow_s = tid >> 3, kch = tid & 7;
    const int vpos0 = ((kch >> 1) * 4 + ((kch & 1) ? 1 : 0)) * 4, vpos1 = ((kch >> 1) * 4 + ((kch & 1) ? 3 : 2)) * 4;
#pragma unroll 1
    for (int r = 0; r < 2; ++r) {
        const bf16* Qp = Q + (tok0 + q0 + r32) * 1024 + (h * 2 + r) * 64;
        bf16x8 qr[4];
#pragma unroll
        for (int d0 = 0; d0 < 4; ++d0) qr[d0] = *(const bf16x8*)(Qp + d0 * 16 + hi * 8);
        asm volatile("" : "+v"(qr[0]), "+v"(qr[1]), "+v"(qr[2]), "+v"(qr[3]));
        const bf16* Kub = K + tok0 * 1024 + (h * 2 + r) * 64; const bf16* Vub = VT + (size_t)(h * 128) * TH + tok0;
        const unsigned klo = (unsigned)(krow_s * 1024 + kch * 8) * 2u, vlo = (unsigned)((tid >> 3) * TH + kch * 8) * 2u;
#define ATT_LDG(UB, OFF) ({ const bf16* ub_ = (UB); asm volatile("" : "+s"(ub_)); *(const u32x4*)((const char*)ub_ + (OFF)); })
        u32x4 kreg = ATT_LDG(Kub, klo), v0reg = ATT_LDG(Kub + (size_t)64 * 1024, klo), v1reg;
        *(LAS u32x4*)(Ks + krow_s * AK_STRIDE + kch * 8) = kreg;
        *(LAS u32x4*)(Ks + 64 * AK_STRIDE + krow_s * AK_STRIDE + kch * 8) = v0reg;
        ATT_BAR();
        f32x16 o[4];
#pragma unroll
        for (int b = 0; b < 4; ++b)
#pragma unroll
            for (int i = 0; i < 16; ++i) o[b][i] = 0.f;
        float lrun = 0.f;
        const int qg = q0 + r32;
        const int wlast = (q0 + 31) >> 6;
        f32x16 p0, p1; bf16x8 pf[4];
#pragma unroll
        for (int s = 0; s < 4; ++s) pf[s] = (bf16x8){0, 0, 0, 0, 0, 0, 0, 0};
#define ATT_QK(KS) do { const LAS bf16* ks_ = (KS); bf16x8 kf[8]; const f32x16 zc = {0.f, 0.f, 0.f, 0.f, 0.f, 0.f, 0.f, 0.f, 0.f, 0.f, 0.f, 0.f, 0.f, 0.f, 0.f, 0.f}; \
        _Pragma("unroll") for (int d0 = 0; d0 < 4; ++d0) { kf[2 * d0] = *(const LAS bf16x8*)(ks_ + d0 * 16); kf[2 * d0 + 1] = *(const LAS bf16x8*)(ks_ + 32 * AK_STRIDE + d0 * 16); } \
        p0 = __builtin_amdgcn_mfma_f32_32x32x16_bf16(kf[0], qr[0], zc, 0, 0, 0); p1 = __builtin_amdgcn_mfma_f32_32x32x16_bf16(kf[1], qr[0], zc, 0, 0, 0); \
        _Pragma("unroll") for (int d0 = 1; d0 < 4; ++d0) { p0 = __builtin_amdgcn_mfma_f32_32x32x16_bf16(kf[2 * d0], qr[d0], p0, 0, 0, 0); p1 = __builtin_amdgcn_mfma_f32_32x32x16_bf16(kf[2 * d0 + 1], qr[d0], p1, 0, 0, 0); } } while (0)
#define ATT_MASK(T) do { if (negshift != 0.f) { _Pragma("unroll") for (int i = 0; i < 16; ++i) { p0[i] += negshift; p1[i] += negshift; } } \
        if (64 * (T) + 63 > q0) { _Pragma("unroll") for (int i = 0; i < 16; ++i) { const int kv = 64 * (T) + crow(i, hi); if (kv > qg) p0[i] = -INFINITY; if (kv + 32 > qg) p1[i] = -INFINITY; } } } while (0)
#define ATT_SM1(P, B, DST) do { float s_ = 0.f; _Pragma("unroll") for (int i = 0; i < 8; ++i) { P[(B) + i] = __builtin_amdgcn_exp2f(P[(B) + i]); s_ += P[(B) + i]; } lrun += s_; u32x4 w_; \
        w_.x = pk2(P[(B)], P[(B) + 1]); w_.y = pk2(P[(B) + 2], P[(B) + 3]); w_.z = pk2(P[(B) + 4], P[(B) + 5]); w_.w = pk2(P[(B) + 6], P[(B) + 7]); DST = __builtin_bit_cast(bf16x8, w_); } while (0)
#define ATT_SM(PFN) do { ATT_SM1(p0, 0, PFN[0]); ATT_SM1(p0, 8, PFN[1]); ATT_SM1(p1, 0, PFN[2]); ATT_SM1(p1, 8, PFN[3]); } while (0)
#define ATT_PVL(VS) const LAS bf16* vs_ = (VS); bf16x8 vfa[4], vfb[4]; \
        _Pragma("unroll") for (int bb = 0; bb < 4; ++bb) vfa[bb] = *(const LAS bf16x8*)(vs_ + 32 * bb * AV_STRIDE);
#define ATT_PVM() do { \
        _Pragma("unroll") for (int bb = 0; bb < 4; ++bb) vfb[bb] = *(const LAS bf16x8*)(vs_ + 32 * bb * AV_STRIDE + 16); \
        _Pragma("unroll") for (int bb = 0; bb < 4; ++bb) o[bb] = __builtin_amdgcn_mfma_f32_32x32x16_bf16(vfa[bb], pf[0], o[bb], 0, 0, 0); \
        _Pragma("unroll") for (int bb = 0; bb < 4; ++bb) vfa[bb] = *(const LAS bf16x8*)(vs_ + 32 * bb * AV_STRIDE + 32); \
        _Pragma("unroll") for (int bb = 0; bb < 4; ++bb) o[bb] = __builtin_amdgcn_mfma_f32_32x32x16_bf16(vfb[bb], pf[1], o[bb], 0, 0, 0); \
        _Pragma("unroll") for (int bb = 0; bb < 4; ++bb) vfb[bb] = *(const LAS bf16x8*)(vs_ + 32 * bb * AV_STRIDE + 48); \
        _Pragma("unroll") for (int bb = 0; bb < 4; ++bb) o[bb] = __builtin_amdgcn_mfma_f32_32x32x16_bf16(vfa[bb], pf[2], o[bb], 0, 0, 0); \
        _Pragma("unroll") for (int bb = 0; bb < 4; ++bb) o[bb] = __builtin_amdgcn_mfma_f32_32x32x16_bf16(vfb[bb], pf[3], o[bb], 0, 0, 0); } while (0)
        ATT_QK(ksl);
        ATT_BAR();
#define ATT_STAGE_LD(T) do { v0reg = ATT_LDG(Vub + (T) * 64, vlo); v1reg = ATT_LDG(Vub + (size_t)64 * TH + (T) * 64, vlo); if ((T) + 2 < NT) kreg = ATT_LDG(Kub + (size_t)((T) + 2) * 64 * 1024, klo); } while (0)
#define ATT_STAGE_ST(T) do { LAS bf16* vd = Vs + ((T) & 1) * 128 * AV_STRIDE + (tid >> 3) * AV_STRIDE; \
        *(LAS u32x2*)(vd + vpos0) = (u32x2){v0reg.x, v0reg.y}; *(LAS u32x2*)(vd + vpos1) = (u32x2){v0reg.z, v0reg.w}; vd += 64 * AV_STRIDE; \
        *(LAS u32x2*)(vd + vpos0) = (u32x2){v1reg.x, v1reg.y}; *(LAS u32x2*)(vd + vpos1) = (u32x2){v1reg.z, v1reg.w}; \
        if ((T) + 2 < NT) *(LAS u32x4*)(Ks + ((T) & 1) * 64 * AK_STRIDE + krow_s * AK_STRIDE + kch * 8) = kreg; } while (0)
        {
            ATT_STAGE_LD(0);
            ATT_MASK(0); ATT_SM(pf);
            if (1 <= wlast) ATT_QK(ksl + 64 * AK_STRIDE);
            ATT_STAGE_ST(0);
            ATT_BAR();
        }
        const int tend = wlast < NT - 1 ? wlast : NT - 1;
#pragma unroll 1
        for (int t = 1; t <= tend; ++t) {
            {
                const int kt = (t + 2 < NT) ? t + 2 : NT - 1;
                v0reg = ATT_LDG(Vub + t * 64, vlo); v1reg = ATT_LDG(Vub + (size_t)64 * TH + t * 64, vlo); kreg = ATT_LDG(Kub + (size_t)kt * 64 * 1024, klo);
            }
            {
                bf16x8 pfn[4];
                ATT_PVL(vsl + ((t - 1) & 1) * 128 * AV_STRIDE)
                ATT_MASK(t);
                ATT_PVM();
                ATT_SM(pfn);
#pragma unroll
                for (int i = 0; i < 16; ++i) { __builtin_amdgcn_sched_group_barrier(0x008, 1, 0); __builtin_amdgcn_sched_group_barrier(0x400, 2, 0); __builtin_amdgcn_sched_group_barrier(0x002, 3, 0); }
#pragma unroll
                for (int s = 0; s < 4; ++s) pf[s] = pfn[s];
            }
            ATT_QK(ksl + ((t + 1) & 1) * 64 * AK_STRIDE);
            {
                LAS bf16* vd = Vs + (t & 1) * 128 * AV_STRIDE + (tid >> 3) * AV_STRIDE;
                *(LAS u32x2*)(vd + vpos0) = (u32x2){v0reg.x, v0reg.y}; *(LAS u32x2*)(vd + vpos1) = (u32x2){v0reg.z, v0reg.w}; vd += 64 * AV_STRIDE;
                *(LAS u32x2*)(vd + vpos0) = (u32x2){v1reg.x, v1reg.y}; *(LAS u32x2*)(vd + vpos1) = (u32x2){v1reg.z, v1reg.w};
                *(LAS u32x4*)(Ks + (t & 1) * 64 * AK_STRIDE + krow_s * AK_STRIDE + kch * 8) = kreg;
            }
            ATT_BAR();
        }
        if (tend < NT - 1) {
            ATT_STAGE_LD(tend + 1);
            { ATT_PVL(vsl + (tend & 1) * 128 * AV_STRIDE) ATT_PVM(); }
            ATT_STAGE_ST(tend + 1);
            ATT_BAR();
#pragma unroll 1
            for (int t = tend + 2; t < NT; ++t) { ATT_STAGE_LD(t); ATT_STAGE_ST(t); ATT_BAR(); }
        }
        if (NT - 1 <= wlast) { ATT_PVL(vsl + ((NT - 1) & 1) * 128 * AV_STRIDE) ATT_PVM(); }
#undef ATT_STAGE_LD
#undef ATT_STAGE_ST
        ATT_BAR();
#undef ATT_QK
#undef ATT_MASK
#undef ATT_SM
#undef ATT_SM1
#undef ATT_PVL
#undef ATT_PVM
#undef ATT_LDG
        const int xidx = (lane ^ 32) << 2;
        const float ltot = lrun + __uint_as_float((unsigned)__builtin_amdgcn_ds_bpermute(xidx, (int)__float_as_uint(lrun)));
        const float inv = 1.0f / ltot;
        if (r == 0) {
#pragma unroll
            for (int b = 0; b < 4; ++b)
#pragma unroll
                for (int i = 0; i < 8; ++i) o0s[(b * 8 + i) * 64] = pk2(o[b][2 * i] * inv, o[b][2 * i + 1] * inv);
        } else {
            float ss = 0.f;
#pragma unroll
            for (int b = 0; b < 4; ++b)
#pragma unroll
                for (int i = 0; i < 8; ++i) { const unsigned w = o0s[(b * 8 + i) * 64];
                    const float v0 = bflo(w) - lam * (o[b][2 * i] * inv), v1 = bfhi(w) - lam * (o[b][2 * i + 1] * inv);
                    o[b][2 * i] = v0; o[b][2 * i + 1] = v1; ss += v0 * v0 + v1 * v1; }
            ss += __uint_as_float((unsigned)__builtin_amdgcn_ds_bpermute(xidx, (int)__float_as_uint(ss)));
            const float rs = rsqrtf(ss * (1.0f / 128.0f) + EPS) * outscale;
            const bf16* Sub = SAZ + tok0 * 1024 + h * 128; bf16* Oub = Oo + tok0 * 1024 + h * 128;
            const int rowoff = (q0 + r32) * 1024;
#pragma unroll
            for (int b = 0; b < 4; ++b)
#pragma unroll
                for (int g4 = 0; g4 < 4; ++g4) {
                    const int e = 32 * b + 8 * g4 + 4 * hi;
                    const f32x4 gv = *(const f32x4*)(ang + e);
                    const u32x2 zw = *(const u32x2*)(Sub + rowoff + e);
                    u32x2 w;
                    w.x = pk2(o[b][4 * g4 + 0] * rs * gv.x * bflo(zw.x), o[b][4 * g4 + 1] * rs * gv.y * bfhi(zw.x));
                    w.y = pk2(o[b][4 * g4 + 2] * rs * gv.z * bflo(zw.y), o[b][4 * g4 + 3] * rs * gv.w * bfhi(zw.y));
                    *(u32x2*)(Oub + rowoff + e) = w;
                    if (g4 & 1) asm volatile("" ::: "memory");
                }
        }
    }
}

constexpr int ML_STRIDE = 72;
__device__ __forceinline__ void conv8(const bf16* BQK, const float* cw, const float* cb, size_t tok0, int c, int t, int ch0, float (&outv)[8]) {
    const f32x4 b0 = *(const f32x4*)(cb + ch0), b1 = *(const f32x4*)(cb + ch0 + 4);
    float a[8] = {b0.x, b0.y, b0.z, b0.w, b1.x, b1.y, b1.z, b1.w};
#pragma unroll
    for (int j = 0; j < 4; ++j) {
        const int tt = t - 3 + j;
        if (c > 0 || tt >= 0) {
            const u32x4 xv = *(const u32x4*)(BQK + (size_t)((long)tok0 + tt) * 1024 + ch0);
            const f32x4 w0 = *(const f32x4*)(cw + j * 1024 + ch0), w1 = *(const f32x4*)(cw + j * 1024 + ch0 + 4);
            a[0] += w0.x * bflo(xv.x); a[1] += w0.y * bfhi(xv.x); a[2] += w0.z * bflo(xv.y); a[3] += w0.w * bfhi(xv.y);
            a[4] += w1.x * bflo(xv.z); a[5] += w1.y * bfhi(xv.z); a[6] += w1.z * bflo(xv.w); a[7] += w1.w * bfhi(xv.w);
        }
    }
#pragma unroll
    for (int i = 0; i < 8; ++i) outv[i] = a[i] * sigm(a[i]);
}
__device__ __forceinline__ float log_sigmoid(float x) { return fminf(x, 0.f) - log1pf(__expf(-fabsf(x))); }
__device__ __forceinline__ float prefix_sum64(float v, int lane) {
#pragma unroll
    for (int o = 1; o < 64; o <<= 1) { const float n = __shfl_up(v, o); if (lane >= o) v += n; }
    return v;
}
__device__ __forceinline__ float prefix_max64(float v, int lane) {
#pragma unroll
    for (int o = 1; o < 64; o <<= 1) { const float n = __shfl_up(v, o); if (lane >= o) v = fmaxf(v, n); }
    return v;
}
__device__ __forceinline__ f32x4 mma16(const LAS bf16* A, const LAS bf16* Bt, int m0, int n0, int fr, int fq) {
    f32x4 acc = {0.f, 0.f, 0.f, 0.f};
#pragma unroll
    for (int k0 = 0; k0 < 64; k0 += 32) {
        const bf16x8 a = *(const LAS bf16x8*)(A + (m0 + fr) * ML_STRIDE + k0 + 8 * fq);
        const bf16x8 b = *(const LAS bf16x8*)(Bt + (n0 + fr) * ML_STRIDE + k0 + 8 * fq);
        acc = __builtin_amdgcn_mfma_f32_16x16x32_bf16(a, b, acc, 0, 0, 0);
    }
    return acc;
}
__device__ __forceinline__ void stage_vt(LAS bf16* Vt, const bf16* VT, int vrow0, size_t tok0, int tid) {
#pragma unroll
    for (int i = 0; i < 2; ++i) { const int idx = tid + 512 * i, e = idx >> 3, ch = idx & 7;
        *(LAS u32x4*)(Vt + e * ML_STRIDE + ch * 8) = *(const u32x4*)(VT + (size_t)(vrow0 + e) * TH + tok0 + ch * 8); }
    if (tid < 128) { const int e = 128 + (tid >> 3), ch = tid & 7; const unsigned v = (e == 128) ? 0x3f803f80u : 0u; *(LAS u32x4*)(Vt + e * ML_STRIDE + ch * 8) = (u32x4){v, v, v, v}; }
}
__device__ __forceinline__ void mlstm_m1(LAS unsigned char* lds, const bf16* BQK, const bf16* VT, const float* GATES, const float* cw, const float* cb, const float* igb, const float* fgb,
                                         float* CST, float* MST, int ci) {
    int tid_l = threadIdx.x; asm volatile("" : "+v"(tid_l));
    const int tid = tid_l, lane = tid & 63, wave = __builtin_amdgcn_readfirstlane(tid >> 6), fr = lane & 15, fq = lane >> 4;
    const int c = ci & 127, h = (ci >> 7) & 7, bl = ci >> 10; const size_t tok0 = (size_t)bl * SEQ + c * 64;
    LAS bf16* KtW = (LAS bf16*)lds; LAS bf16* Vt = (LAS bf16*)(lds + 64 * ML_STRIDE * 2); LAS float* wsh = (LAS float*)(lds + (64 + 144) * ML_STRIDE * 2);
    if (wave == 0) {
        const float fp = GATES[(tok0 + lane) * 16 + 8 + h] + fgb[h], ip = GATES[(tok0 + lane) * 16 + h] + igb[h];
        const float b = prefix_sum64(log_sigmoid(fp), lane);
        const float blast = __shfl(b, 63);
        const float wl = blast - b + ip; const float ml = wave_max(wl);
        wsh[lane] = __expf(wl - ml);
        if (lane == 0) { MST[ci * 4 + 0] = ml; MST[ci * 4 + 1] = blast; }
    }
    stage_vt(Vt, VT, 1024 + h * 128, tok0, tid);
    float kv[8]; const int t = tid >> 3, d8 = (tid & 7) * 8;
    conv8(BQK, cw, cb, tok0, c, t, 512 + h * 64 + d8, kv);
    __syncthreads();
    { const float w = wsh[t];
#pragma unroll
      for (int i = 0; i < 8; ++i) KtW[(d8 + i) * ML_STRIDE + t] = (bf16)f2bf(kv[i] * w); }
    __syncthreads();
    const int nb = wave & 3, half = wave >> 2; bf16* cst = (bf16*)CST + (size_t)ci * CST_STRIDE;
#pragma unroll
    for (int j = 0; j < 4; ++j) { const int mb = half * 4 + j; const f32x4 a = mma16(Vt, KtW, 16 * mb, 16 * nb, fr, fq);
#pragma unroll
        for (int i = 0; i < 4; ++i) cst[(16 * mb + 4 * fq + i) * 64 + 16 * nb + fr] = (bf16)f2bf(a[i]); }
    if (half == 0) { const f32x4 a = mma16(Vt, KtW, 128, 16 * nb, fr, fq); if (fq == 0) cst[128 * 64 + 16 * nb + fr] = (bf16)f2bf(a[0]); }
    __syncthreads();
}
__device__ __forceinline__ void mlstm_m2(float* CST, float* MST) {
    int t_l = threadIdx.x; asm volatile("" : "+v"(t_l));
    constexpr int NPAIR = CST_STRIDE / 2;
#pragma unroll 1
    for (int g = blockIdx.x * 512 + t_l; g < 16 * NPAIR; g += gridDim.x * 512) {
        const int seq = g / NPAIR, pr = g % NPAIR;
        float m = -1e30f, st0 = 0.f, st1 = 0.f;
        unsigned* p = (unsigned*)CST + (size_t)seq * 128 * NPAIR + pr; float* ms = MST + (size_t)seq * 128 * 4;
#pragma unroll 1
        for (int c0 = 0; c0 < 128; c0 += 16) {
            unsigned cw[16]; float ml[16], bl[16];
#pragma unroll
            for (int j = 0; j < 16; ++j) { cw[j] = p[(size_t)(c0 + j) * NPAIR]; ml[j] = ms[(c0 + j) * 4 + 0]; bl[j] = ms[(c0 + j) * 4 + 1]; }
#pragma unroll
            for (int j = 0; j < 16; ++j) {
                const float mnew = fmaxf(bl[j] + m, ml[j]); const float a = __expf(bl[j] + m - mnew), e = __expf(ml[j] - mnew);
                p[(size_t)(c0 + j) * NPAIR] = pk2(st0, st1); if (pr == 0) ms[(c0 + j) * 4 + 2] = m;
                st0 = a * st0 + e * bflo(cw[j]); st1 = a * st1 + e * bfhi(cw[j]); m = mnew;
            }
        }
    }
}
__device__ __forceinline__ void mlstm_m3(LAS unsigned char* lds, const bf16* BQK, const bf16* VT, const float* GATES, const float* cw, const float* cb, const float* igb, const float* fgb,
                                         const float* CST, const float* MST, const float* mng, const bf16* BOG, bf16* HB, int ci) {
    int tid_l = threadIdx.x; asm volatile("" : "+v"(tid_l));
    const int tid = tid_l, lane = tid & 63, wave = __builtin_amdgcn_readfirstlane(tid >> 6), fr = lane & 15, fq = lane >> 4;
    const int c = ci & 127, h = (ci >> 7) & 7, bl = ci >> 10; const size_t tok0 = (size_t)bl * SEQ + c * 64;
    constexpr int RB = ML_STRIDE * 2;
    LAS bf16* Qs = (LAS bf16*)lds; LAS bf16* Ks = (LAS bf16*)(lds + 64 * RB); LAS bf16* Vt = (LAS bf16*)(lds + 128 * RB); LAS bf16* Ct = (LAS bf16*)(lds + 272 * RB);
    LAS bf16* Ps = (LAS bf16*)(lds + 416 * RB); LAS float* Hs = (LAS float*)(lds + 480 * RB); LAS float* gsh = (LAS float*)(lds + 480 * RB + 64 * 132 * 4);
    if (wave == 0) {
        const float fp = GATES[(tok0 + lane) * 16 + 8 + h] + fgb[h], ip = GATES[(tok0 + lane) * 16 + h] + igb[h];
        const float b = prefix_sum64(log_sigmoid(fp), lane);
        const float g = ip - b; const float pm = prefix_max64(g, lane);
        const float mprev = MST[ci * 4 + 2];
        const float M = fmaxf(mprev, pm);
        gsh[lane] = g; gsh[64 + lane] = M; gsh[128 + lane] = __expf(mprev - M); gsh[192 + lane] = __expf(-(b + M));
    }
    stage_vt(Vt, VT, 1024 + h * 128, tok0, tid);
    { const bf16* cst = (const bf16*)CST + (size_t)ci * CST_STRIDE;
      for (int i = tid; i < 129 * 8; i += 512) { const int e = i >> 3, ch = i & 7; *(LAS u32x4*)(Ct + e * ML_STRIDE + ch * 8) = *(const u32x4*)(cst + e * 64 + ch * 8); }
      if (tid < 120) { const int e = 129 + (tid >> 3), ch = tid & 7; unsigned z = 0u; asm volatile("" : "+v"(z)); *(LAS u32x4*)(Ct + e * ML_STRIDE + ch * 8) = (u32x4){z, z, z, z}; } }
    { float v[8]; const int t = tid >> 3, d8 = (tid & 7) * 8;
      conv8(BQK, cw, cb, tok0, c, t, h * 64 + d8, v);
      *(LAS u32x4*)(Qs + t * ML_STRIDE + d8) = (u32x4){pk2(v[0] * 0.125f, v[1] * 0.125f), pk2(v[2] * 0.125f, v[3] * 0.125f), pk2(v[4] * 0.125f, v[5] * 0.125f), pk2(v[6] * 0.125f, v[7] * 0.125f)};
      conv8(BQK, cw, cb, tok0, c, t, 512 + h * 64 + d8, v);
      *(LAS u32x4*)(Ks + t * ML_STRIDE + d8) = (u32x4){pk2(v[0], v[1]), pk2(v[2], v[3]), pk2(v[4], v[5]), pk2(v[6], v[7])}; }
    __syncthreads();
    { const int mb = wave & 3;
#pragma unroll
      for (int j = 0; j < 2; ++j) { const int nb = (wave >> 2) * 2 + j;
          f32x4 a = {0.f, 0.f, 0.f, 0.f};
          if (nb <= mb) a = mma16(Qs, Ks, 16 * mb, 16 * nb, fr, fq);
          const int s = 16 * nb + fr; const float gs = gsh[s];
#pragma unroll
          for (int i = 0; i < 4; ++i) { const int t = 16 * mb + 4 * fq + i; const float sc = (s <= t) ? a[i] * __expf(gs - gsh[64 + t]) : 0.f; Ps[t * ML_STRIDE + s] = (bf16)f2bf(sc); } } }
    __syncthreads();
    { const int mb = wave & 3, half = wave >> 2;
      f32x4 dn = mma16(Ps, Vt, 16 * mb, 128, fr, fq); const f32x4 dn2 = mma16(Qs, Ct, 16 * mb, 128, fr, fq);
      float den[4], iwv[4], emv[4];
#pragma unroll
      for (int i = 0; i < 4; ++i) { const int t = 16 * mb + 4 * fq + i; iwv[i] = gsh[128 + t]; emv[i] = gsh[192 + t]; const float d = dn[i] + iwv[i] * dn2[i]; den[i] = __shfl(d, lane & 48); }
#pragma unroll
      for (int j = 0; j < 4; ++j) { const int eb = half * 4 + j;
          const f32x4 a1 = mma16(Ps, Vt, 16 * mb, 16 * eb, fr, fq), a2 = mma16(Qs, Ct, 16 * mb, 16 * eb, fr, fq);
#pragma unroll
          for (int i = 0; i < 4; ++i) { const int t = 16 * mb + 4 * fq + i; Hs[t * 132 + 16 * eb + fr] = (a1[i] + iwv[i] * a2[i]) / fmaxf(fabsf(den[i]), emv[i]); } } }
    __syncthreads();
#pragma unroll
    for (int j = 0; j < 8; ++j) { const int t = wave * 8 + j; const float v0 = Hs[t * 132 + 2 * lane], v1 = Hs[t * 132 + 2 * lane + 1];
        const float rs = rsqrtf(wave_sum(v0 * v0 + v1 * v1) * (1.0f / 128.0f) + EPS);
        const size_t off = (tok0 + t) * 1024 + h * 128 + 2 * lane; const unsigned gw = *(const unsigned*)(BOG + off);
        *(unsigned*)(HB + off) = pk2(v0 * rs * mng[2 * lane] * bflo(gw), v1 * rs * mng[2 * lane + 1] * bfhi(gw)); }
    __syncthreads();
}

#define XB_TMO      128
#define XB_XCNT(j)  (256  + 64 * (j))
#define XB_XSUB(j)  (1280 + 64 * (j))
#define XB_XGEN(j)  (2304 + 64 * (j))
#define XB_TOP      3328
#define XB_TOPGEN   3392
#define XCD_BAR_WORDS 3456
#define XB_SPIN_CAP (1u << 18)

__device__ __forceinline__ unsigned xb_ld(unsigned* p)              { return __hip_atomic_load(p, __ATOMIC_RELAXED, __HIP_MEMORY_SCOPE_AGENT); }
__device__ __forceinline__ unsigned xb_add(unsigned* p, unsigned v) { return __hip_atomic_fetch_add(p, v, __ATOMIC_RELAXED, __HIP_MEMORY_SCOPE_AGENT); }
__device__ __forceinline__ unsigned xb_xcc_id() { return (unsigned)__builtin_amdgcn_s_getreg((3 << 11) | 20) & 0xFu; }
#define XB_SPIN(cond, bar) do { unsigned _sp = 0; while (cond) { __builtin_amdgcn_s_sleep(1); \
    if ((++_sp & 255u) == 0u) { if (xb_ld(&(bar)[XB_TMO])) break; if (_sp > XB_SPIN_CAP) { atomicAdd(&(bar)[XB_TMO], 1u); break; } } } } while (0)

struct XcdBarrier {
    unsigned* bar; unsigned x;
    volatile LAS unsigned* st;
};

__device__ __forceinline__ XcdBarrier xcd_barrier_post(unsigned* bar, volatile LAS unsigned* st) {
    XcdBarrier b; b.bar = bar; b.x = xb_xcc_id(); b.st = st;
    if (threadIdx.x == 0) (void)xb_add(&bar[XB_XCNT(b.x)], 1u);
    return b;
}
__device__ __forceinline__ void xcd_barrier_complete(unsigned* bar, unsigned x, unsigned& nloc, unsigned& nx) {
    const unsigned G = gridDim.x * gridDim.y * gridDim.z;
    unsigned sum, cnt, mine, sp = 0u;
    for (;;) {
        sum = 0u; cnt = 0u; mine = 0u;
#pragma unroll
        for (unsigned j = 0; j < 16; ++j) { const unsigned c = xb_ld(&bar[XB_XCNT(j)]); sum += c; cnt += (c > 0u) ? 1u : 0u; mine = (j == x) ? c : mine; }
        if (sum == G) break;
        __builtin_amdgcn_s_sleep(1);
        if ((++sp & 255u) == 0u) { if (xb_ld(&bar[XB_TMO])) break; if (sp > XB_SPIN_CAP) { atomicAdd(&bar[XB_TMO], 1u); break; } }
    }
    nloc = mine > 0u ? mine : 1u; nx = cnt > 0u ? cnt : 1u;
}

__device__ __forceinline__ void xcd_barrier(const XcdBarrier& b) {
    asm volatile("s_waitcnt vmcnt(0)" ::: "memory");
    __syncthreads();
    if (threadIdx.x == 0) {
        unsigned* bar = b.bar;
        __builtin_amdgcn_s_waitcnt(0);
        unsigned nloc = b.st[0], nx = b.st[1];
        if (nloc == 0u) { xcd_barrier_complete(bar, b.x, nloc, nx); b.st[0] = nloc; b.st[1] = nx; }
        const unsigned old = xb_add(&bar[XB_XSUB(b.x)], 1u);
        const unsigned gen = old / nloc;
        if (old + 1u == (gen + 1u) * nloc) {
            __builtin_amdgcn_fence(__ATOMIC_RELEASE, "agent");
            asm volatile("s_waitcnt vmcnt(0)" ::: "memory");
            const unsigned og = xb_add(&bar[XB_TOP], 1u);
            const unsigned tg = og / nx;
            if (og + 1u == (tg + 1u) * nx) xb_add(&bar[XB_TOPGEN], 1u);
            else XB_SPIN(xb_ld(&bar[XB_TOPGEN]) == tg, bar);
            __builtin_amdgcn_fence(__ATOMIC_ACQUIRE, "agent");
            xb_add(&bar[XB_XGEN(b.x)], 1u);
            asm volatile("s_waitcnt vmcnt(0)" ::: "memory");
        } else {
            XB_SPIN(xb_ld(&bar[XB_XGEN(b.x)]) == gen, bar);
            __builtin_amdgcn_fence(__ATOMIC_ACQUIRE, "agent");
            asm volatile("s_waitcnt vmcnt(0)" ::: "memory");
        }
    }
    __syncthreads();
}
#define KPL() ({ KParams k_ = KP0; asm volatile("" : "+s"(k_)); k_; })
#define WSP(T, off) ((T*)(ws + (off)))
__device__ __forceinline__ int tid_fresh() { int t = threadIdx.x; asm volatile("" : "+v"(t)); return t; }
#ifndef NREP_B
#define NREP_B 1
#endif
#ifndef NREP_F
#define NREP_F 1
#endif
#ifndef NREP_P
#define NREP_P 1
#endif
#ifndef NREP_M
#define NREP_M 1
#endif
#ifndef NREP_ATT
#define NREP_ATT 1
#endif
#define GRID_SYNC() do { XcdBarrier xb_; xb_.bar = (unsigned*)(KPL()->ws + WS_CTL) + 4096; xb_.x = xb_xcc_id(); xb_.st = (volatile LAS unsigned*)(lds + LDS_BYTES - 64); xcd_barrier(xb_); } while (0)
__global__ void __launch_bounds__(512, 2) hybrid_fwd(Params P_unused) {
    extern __shared__ __attribute__((aligned(16))) unsigned char lds_raw[];
    LAS unsigned char* lds = (LAS unsigned char*)lds_raw;
    const KParams KP0 = (KParams)__builtin_amdgcn_kernarg_segment_ptr();
    const int G = gridDim.x, bx = blockIdx.x;
    volatile LAS unsigned* xb_st = (volatile LAS unsigned*)(lds + LDS_BYTES - 64);
    if (threadIdx.x < 2) xb_st[threadIdx.x] = 0u;
    __syncthreads();
    (void)xcd_barrier_post((unsigned*)(KP0->ws + WS_CTL) + 4096, xb_st);
    cg::this_grid().sync();
#pragma unroll 1
    for (int rep = 0; rep < NREP_P; ++rep)
    { const int tid = tid_fresh(); prologue(KPL(), lds, __builtin_amdgcn_readfirstlane(tid >> 6), tid & 63); }
#pragma unroll 1
    for (int l_o = 0; l_o < NLAYER; ++l_o) {
#pragma unroll 1
        for (int hf_o = 0; hf_o < 2; ++hf_o) {
            { KParams kp = KPL(); unsigned char* ws = kp->ws; int l = l_o, hf = hf_o; asm volatile("" : "+s"(l), "+s"(hf)); (void)l; (void)hf; const int tid = tid_fresh();
              const float* xin = (l == 0 ? kp->in[0] : kp->out) + (size_t)hf * TH * DM;
              rmsnorm_phase(xin, kp->in[2] + l * DM, WSP(bf16, WS_H), __builtin_amdgcn_readfirstlane(tid >> 6), tid & 63); }
            GRID_SYNC();
#pragma unroll 1
            for (int rep = 0; rep < NREP_B; ++rep)
            { KParams kp = KPL(); unsigned char* ws = kp->ws; int l = l_o, hf = hf_o; asm volatile("" : "+s"(l), "+s"(hf)); (void)l; (void)hf;
              gates_phase(WSP(const bf16, WS_H), WSP(const bf16, WS_WTIN) + ((size_t)l * WT_ROWS + 8192) * 1024, WSP(float, WS_GATES)); }
            { KParams kp = KPL(); unsigned char* ws = kp->ws; int l = l_o, hf = hf_o; asm volatile("" : "+s"(l), "+s"(hf)); (void)l; (void)hf; const bf16* WTin = WSP(const bf16, WS_WTIN) + (size_t)l * WT_ROWS * 1024;
              { pg8::Gemm g{WSP(bf16, WS_H), WTin, TH, 8192, 1024}; pg8::StaticOrder S; S.init(TH, 8192, G, bx);
                pg8::EpiMain E{ws,
                               kp->in[4] + l * 64, kp->in[5] + l * 64, WSP(const float, WS_COS) + (size_t)hf * TH * 32, WSP(const float, WS_SIN) + (size_t)hf * TH * 32, QSCALE};
                pg8::gemm_phase<pg8::EpiMain, pg8::StaticOrder, true, false>(lds, g, S, E); }
              { pg8::Gemm g{WTin + (size_t)8448 * 1024, WSP(bf16, WS_H), 2048, TH, 1024}; pg8::StaticOrder S; S.init(2048, TH, G, bx);
                pg8::EpiPlain E{WSP(bf16, WS_VT), TH};
                pg8::gemm_phase<pg8::EpiPlain, pg8::StaticOrder, true, true>(lds, g, S, E); } }
            GRID_SYNC();
#pragma unroll 1
            for (int rep = 0; rep < NREP_M; ++rep)
            { KParams kp = KPL(); unsigned char* ws = kp->ws; int l = l_o, hf = hf_o; asm volatile("" : "+s"(l), "+s"(hf)); (void)l; (void)hf;
              for (int ci = bx; ci < NCHUNK_H; ci += G)
                  mlstm_m1(lds, WSP(bf16, WS_BQK), WSP(bf16, WS_VT), WSP(float, WS_GATES), kp->in[9] + l * 4096, kp->in[10] + l * 1024, kp->in[11] + l * 8, kp->in[12] + l * 8, WSP(float, WS_CST), WSP(float, WS_MST), ci); }
            GRID_SYNC();
            { KParams kp = KPL(); unsigned char* ws = kp->ws; int l = l_o, hf = hf_o; asm volatile("" : "+s"(l), "+s"(hf)); (void)l; (void)hf; mlstm_m2(WSP(float, WS_CST), WSP(float, WS_MST)); }
            GRID_SYNC();
#pragma unroll 1
            for (int ord = 0; ord < 2; ++ord) {
              const bool run_m3 = ((ord == 0) != (((bx >> 3) & 1) != 0));
              if (run_m3) {
#pragma unroll 1
            for (int rep = 0; rep < NREP_M; ++rep)
            { KParams kp = KPL(); unsigned char* ws = kp->ws; int l = l_o, hf = hf_o; asm volatile("" : "+s"(l), "+s"(hf)); (void)l; (void)hf;
              for (int ci = bx; ci < NCHUNK_H; ci += G)
                  mlstm_m3(lds, WSP(bf16, WS_BQK), WSP(bf16, WS_VT), WSP(float, WS_GATES), kp->in[9] + l * 4096, kp->in[10] + l * 1024, kp->in[11] + l * 8, kp->in[12] + l * 8,
                           WSP(float, WS_CST), WSP(float, WS_MST), kp->in[13] + l * 128, WSP(bf16, WS_BOG), WSP(bf16, WS_H), ci); }
              } else {
            { KParams kp = KPL(); unsigned char* ws = kp->ws; int l = l_o, hf = hf_o; asm volatile("" : "+s"(l), "+s"(hf)); (void)l; (void)hf; const int lane = tid_fresh() & 63;
              const float* lq = kp->in[6] + l * 256; const float s1 = wave_sum(lq[lane] * lq[64 + lane]), s2 = wave_sum(lq[128 + lane] * lq[192 + lane]);
              const float lam_init = kp->lam_init[l]; const float lam = __expf(s1) - __expf(s2) + lam_init;
              const float gqm = wave_max(fabsf(kp->in[4][l * 64 + lane])), gkm = wave_max(fabsf(kp->in[5][l * 64 + lane]));
              const float negshift = -fmaxf(0.f, QSCALE * 64.0f * gqm * gkm - 24.0f);
#pragma unroll 1
              for (int rep = ((l_o == 0 && hf_o == 0) ? NREP_ATT : 1) - 1; rep >= 0; --rep)
              for (int pr = bx; pr < 256; pr += G) {
                  const int pv = (G == 256) ? ((pr & 7) * 32 + (pr >> 3)) : pr;
                  const int bl = pv >> 7, h = (pv >> 4) & 7, s = pv & 15;
                  attn_unit(lds, WSP(bf16, WS_Q), rep ? (bf16*)kp->out : WSP(bf16, WS_Q), WSP(bf16, WS_K), WSP(bf16, WS_VT), WSP(bf16, WS_SAZ), kp->in[7] + l * 128, lam, 1.0f - lam_init, negshift, bl, h, 31 - s);
                  attn_unit(lds, WSP(bf16, WS_Q), rep ? (bf16*)kp->out : WSP(bf16, WS_Q), WSP(bf16, WS_K), WSP(bf16, WS_VT), WSP(bf16, WS_SAZ), kp->in[7] + l * 128, lam, 1.0f - lam_init, negshift, bl, h, s);
              } }
              }
            }
            GRID_SYNC();
#pragma unroll 1
            for (int rep = 0; rep < NREP_F; ++rep)
            { KParams kp = KPL(); unsigned char* ws = kp->ws; int l = l_o, hf = hf_o; asm volatile("" : "+s"(l), "+s"(hf)); (void)l; (void)hf;
              { pg8::Gemm g{WSP(bf16, WS_Q), WSP(const bf16, WS_WTOA) + (size_t)l * 1024 * 1024, TH, 1024, 1024}; pg8::StaticOrder S; S.init(TH, 1024, G, bx);
                pg8::EpiOutA E{WSP(bf16, WS_K), WSP(bf16, WS_SGA)};
                pg8::gemm_phase<pg8::EpiOutA, pg8::StaticOrder, true, true>(lds, g, S, E); }
              { pg8::Gemm g{WSP(bf16, WS_H), WSP(const bf16, WS_WTOB) + (size_t)l * 1024 * 1024, TH, 1024, 1024}; pg8::StaticOrder S; S.init(TH, 1024, G, bx);
                pg8::EpiOutB E{WSP(bf16, WS_K), WSP(bf16, WS_SGB)};
                pg8::gemm_phase<pg8::EpiOutB, pg8::StaticOrder, true, true>(lds, g, S, E); } }
            GRID_SYNC();
            { KParams kp = KPL(); unsigned char* ws = kp->ws; int l = l_o, hf = hf_o; asm volatile("" : "+s"(l), "+s"(hf)); (void)l; (void)hf;
              const float* xin = (l == 0 ? kp->in[0] : kp->out) + (size_t)hf * TH * DM; float* xout = kp->out + (size_t)hf * TH * DM;
              pg8::Gemm g{WSP(bf16, WS_K), WSP(const bf16, WS_WTO) + (size_t)l * 1024 * 1024, TH, 1024, 1024}; pg8::StaticOrder S; S.init(TH, 1024, G, bx);
              pg8::EpiFinal E{xin, xout};
              pg8::gemm_phase<pg8::EpiFinal, pg8::StaticOrder, true, true>(lds, g, S, E); }
            __syncthreads();
        }
    }
}

extern "C" void kernel_launch(void* const* d_in, const int* in_sizes, int n_in, void* d_out, int out_size, void* d_ws, size_t ws_size, hipStream_t stream) {
    static int grid_blocks = 0;
    if (grid_blocks == 0) {
        if (n_in != 16 || out_size != NTOK * DM || ws_size < WS_END) { fprintf(stderr, "kernel_launch: unexpected shapes / workspace (%d inputs, out %d, ws %zu)\n", n_in, out_size, ws_size); grid_blocks = -1; return; }
        int dev = 0, cus = 0, per_cu = 0;
        hipGetDevice(&dev); hipDeviceGetAttribute(&cus, hipDeviceAttributeMultiprocessorCount, dev);
        hipFuncSetAttribute((const void*)hybrid_fwd, hipFuncAttributeMaxDynamicSharedMemorySize, LDS_BYTES);
        hipOccupancyMaxActiveBlocksPerMultiprocessor(&per_cu, (const void*)hybrid_fwd, 512, LDS_BYTES);
        (void)hipGetLastError();
        if (per_cu < 1) per_cu = 1;
        grid_blocks = cus;
    }
    if (grid_blocks < 0) return;
    Params p{};
    for (int i = 0; i < 16; ++i) p.in[i] = (const float*)d_in[i];
    p.out = (float*)d_out; p.ws = (unsigned char*)d_ws;
    for (int i = 0; i < 32; ++i) p.inv_freq[i] = (float)pow(10000.0, -(double)(2 * i) / 64.0);
    for (int l = 0; l < 2; ++l) p.lam_init[l] = (float)(0.8 - 0.6 * exp(-0.3 * (double)l));
    if (hipMemsetAsync((char*)d_ws + WS_CTL, 0, 65536, stream) != hipSuccess) { fprintf(stderr, "kernel_launch: memset of the barrier words failed\n"); return; }
    void* args[] = {&p};
    hipError_t e = hipLaunchCooperativeKernel((void*)hybrid_fwd, dim3(grid_blocks), dim3(512), args, LDS_BYTES, stream);
    if (e != hipSuccess) fprintf(stderr, "cooperative launch failed: %s (grid %d)\n", hipGetErrorString(e), grid_blocks);
}
```

```cpp
#include <hip/hip_runtime.h>
#include <cstdio>
#include <cstdint>
#include <cmath>
constexpr int NB = 4, SEQ = 8192, DM = 1024, NTOK = NB * SEQ, TH = NTOK / 2, NLAYER = 2, DIN = 10256;
constexpr int WT_ROWS = 10496;
constexpr int NCHUNK_H = 2 * 8 * 128;
constexpr int CST_STRIDE = 129 * 64;
constexpr float EPS = 1e-6f;
constexpr float QSCALE = 0.125f * 1.4426950408889634f;
constexpr size_t MiB = 1u << 20;
constexpr size_t WS_CTL = 0, WS_WTIN = 1 * MiB, WS_WTOA = 43 * MiB, WS_WTOB = 47 * MiB, WS_WTO = 51 * MiB, WS_COS = 55 * MiB, WS_SIN = 59 * MiB,
                 WS_H = 64 * MiB, WS_Q = 96 * MiB, WS_K = 128 * MiB, WS_SAZ = 160 * MiB, WS_BQK = 192 * MiB, WS_VT = 224 * MiB, WS_BOG = 288 * MiB,
                 WS_SGA = 320 * MiB, WS_SGB = 352 * MiB, WS_GATES = 384 * MiB, WS_MST = 385 * MiB, WS_CST = 386 * MiB, WS_END = 452 * MiB;
static_assert((size_t)WT_ROWS * 1024 * 2 * 2 <= WS_WTOA - WS_WTIN, "wt_in copies");
static_assert((size_t)NCHUNK_H * CST_STRIDE * 4 <= WS_END - WS_CST, "states");
namespace pg8 {
#define PG8_LAS __attribute__((address_space(3)))
typedef unsigned short bf16_t;
typedef short bf16x8 __attribute__((ext_vector_type(8)));
typedef float f32x4 __attribute__((ext_vector_type(4)));
typedef unsigned u32x4 __attribute__((ext_vector_type(4)));
constexpr int BM = 256, BK = 64, HALF = 128, HTB = HALF * BK * 2  , STAGE_BYTES = 8 * HTB, NXCD = 8, WGM = 8;

__host__ __device__ __forceinline__ int lds_byte(int r, int c) { const int st = (r >> 4) * 2 + (c >> 5), rr = r & 15, cc = c & 31, ob = rr * 64 + cc * 2; return st * 1024 + (ob ^ (((ob >> 9) & 1) << 5)); }
__host__ __device__ __forceinline__ void stage_rc(int b, int& R, int& C) { const int st = b / 1024, sb = b % 1024, swz = sb ^ (((sb >> 9) & 1) << 5); R = (st >> 1) * 16 + swz / 64; C = (st & 1) * 32 + (swz % 64) / 2; }
__host__ __device__ __forceinline__ int perm32(int rho) { const int n = rho >> 4, i = rho & 15; return 8 * (i >> 2) + 4 * n + (i & 3); }

struct Unit { int pm, pn; };
struct Gemm { const bf16_t* A; const bf16_t* Bt; int M, N, K; };

struct StaticOrder {
    int nM, nN, nwg, G, c;
    __host__ __device__ void init(int M, int N, int G_, int c_) { nM = M / BM; nN = N / BM; nwg = nM * nN; G = G_; c = c_; }
    __host__ __device__ bool next(int i, Unit& u) const {
        const long L = (long)i * G + c; if (L >= nwg) return false;
        int wgid = (int)L; { const int q = nwg / NXCD, r = nwg % NXCD, xcd = wgid % NXCD, off = wgid / NXCD; wgid = (xcd < r ? xcd * (q + 1) : r * (q + 1) + (xcd - r) * q) + off; }
        const int nig = WGM * nN, gid = wgid / nig, fm = gid * WGM, gsz = (nM - fm) < WGM ? (nM - fm) : WGM;
        u.pm = fm + ((wgid % nig) % gsz); u.pn = (wgid % nig) / gsz; return true;
    }
    __device__ __forceinline__ void a_ready(const Unit&) const {}
    __device__ __forceinline__ void done(const Unit&) const {}
};

typedef float f32x2c_t __attribute__((ext_vector_type(2))); typedef __bf16 bf16x2c_t __attribute__((ext_vector_type(2)));
__device__ __forceinline__ unsigned cvt_pk_bf16(float lo, float hi) { f32x2c_t v = {lo, hi}; bf16x2c_t b = __builtin_convertvector(v, bf16x2c_t); return __builtin_bit_cast(unsigned, b); }
typedef float f32x2 __attribute__((ext_vector_type(2)));
typedef unsigned u32x4e __attribute__((ext_vector_type(4)));
__device__ __forceinline__ float sigm(float x) { return __builtin_amdgcn_rcpf(1.0f + __expf(-x)); }
__device__ __forceinline__ u32x4e pack8(const f32x4& a, const f32x4& b) { u32x4e w; w.x = cvt_pk_bf16(a[0], a[1]); w.y = cvt_pk_bf16(a[2], a[3]); w.z = cvt_pk_bf16(b[0], b[1]); w.w = cvt_pk_bf16(b[2], b[3]); return w; }
__device__ __forceinline__ float bf_lo(unsigned w) { return __uint_as_float(w << 16); }
__device__ __forceinline__ float bf_hi(unsigned w) { return __uint_as_float(w & 0xffff0000u); }
__device__ __forceinline__ void unpack8(const u32x4e w, f32x4& a, f32x4& b) { a[0] = bf_lo(w.x); a[1] = bf_hi(w.x); a[2] = bf_lo(w.y); a[3] = bf_hi(w.y); b[0] = bf_lo(w.z); b[1] = bf_hi(w.z); b[2] = bf_lo(w.w); b[3] = bf_hi(w.w); }

struct EpiPlain {
    static constexpr bool PERM = true, AFTER_DRAIN = false;
    bf16_t* O; int ldc;
    __device__ __forceinline__ void operator()(const f32x4 (&acc)[2][2][4][2], const Unit& u, int wr, int wc, int fr, int fq) const {
        const int row0 = u.pm * BM + wr * 64 + fr, col0 = u.pn * BM + wc * 32 + 8 * fq;
#pragma unroll
        for (int ai = 0; ai < 2; ++ai)
#pragma unroll
            for (int m = 0; m < 4; ++m) { bf16_t* rowp = O + (size_t)(row0 + ai * HALF + m * 16) * ldc + col0;
#pragma unroll
                for (int bj = 0; bj < 2; ++bj) *(u32x4e*)(rowp + bj * HALF) = pack8(acc[ai][bj][m][0], acc[ai][bj][m][1]); }
    }
};

struct EpiMain {
    static constexpr bool PERM = true, AFTER_DRAIN = false;
    unsigned char* ws;
    const float *qg, *kg;
    const float *cosT, *sinT;
    float qscale;
    __device__ __forceinline__ void operator()(const f32x4 (&acc)[2][2][4][2], const Unit& u, int wr, int wc, int fr, int fq) const {
        const int pn = u.pn; const int row0 = u.pm * BM + wr * 64 + fr; const int x0 = wc * 32 + 8 * fq;
        if (pn < 8) {
            bf16_t* O = (bf16_t*)(ws + (pn < 4 ? WS_Q : WS_K)); const float* g = pn < 4 ? qg : kg; const float sc = pn < 4 ? qscale : 1.0f;
            const int gcol = (pn & 3) * 256 + wc * 64, j0 = 8 * fq;
#pragma unroll
            for (int ai = 0; ai < 2; ++ai)
#pragma unroll
                for (int m = 0; m < 4; ++m) {
                    const int row = row0 + ai * HALF + m * 16;
                    float ss = 0.f;
#pragma unroll
                    for (int bj = 0; bj < 2; ++bj)
#pragma unroll
                        for (int n = 0; n < 2; ++n) { const f32x4 v = acc[ai][bj][m][n]; ss += (v[0] * v[0] + v[1] * v[1]) + (v[2] * v[2] + v[3] * v[3]); }
                    ss += __shfl_xor(ss, 16); ss += __shfl_xor(ss, 32);
                    const float rs = rsqrtf(ss * (1.0f / 64.0f) + 1e-6f);
                    bf16_t* rowp = O + (size_t)row * 1024 + gcol + j0;
                    u32x4e w1, w2;
#pragma unroll
                    for (int n = 0; n < 2; ++n) {
                        const f32x4 cc = *(const f32x4*)(cosT + (size_t)row * 32 + j0 + 4 * n), sn = *(const f32x4*)(sinT + (size_t)row * 32 + j0 + 4 * n);
                        const f32x4 ga = *(const f32x4*)(g + j0 + 4 * n), gb = *(const f32x4*)(g + 32 + j0 + 4 * n);
                        const f32x4 a = acc[ai][0][m][n] * rs * ga, b = acc[ai][1][m][n] * rs * gb;
                        const f32x4 o1 = (a * cc - b * sn) * sc, o2 = (b * cc + a * sn) * sc;
                        if (n == 0) { w1.x = cvt_pk_bf16(o1[0], o1[1]); w1.y = cvt_pk_bf16(o1[2], o1[3]); w2.x = cvt_pk_bf16(o2[0], o2[1]); w2.y = cvt_pk_bf16(o2[2], o2[3]); }
                        else        { w1.z = cvt_pk_bf16(o1[0], o1[1]); w1.w = cvt_pk_bf16(o1[2], o1[3]); w2.z = cvt_pk_bf16(o2[0], o2[1]); w2.w = cvt_pk_bf16(o2[2], o2[3]); }
                    }
                    *(u32x4e*)(rowp) = w1;
                    *(u32x4e*)(rowp + 32) = w2;
                    if (m == 3) asm volatile("" ::: "memory");
                }
        } else if (pn < 16) {
            bf16_t* O = (bf16_t*)(ws + (pn < 12 ? WS_SAZ : WS_BQK)); const bool act = pn < 12; const int colt = (pn & 3) * 256 + x0;
#pragma unroll
            for (int ai = 0; ai < 2; ++ai)
#pragma unroll
                for (int m = 0; m < 4; ++m) { bf16_t* rowp = O + (size_t)(row0 + ai * HALF + m * 16) * 1024 + colt;
#pragma unroll
                    for (int bj = 0; bj < 2; ++bj) { f32x4 v0 = acc[ai][bj][m][0], v1 = acc[ai][bj][m][1];
                        if (act) {
#pragma unroll
                            for (int e = 0; e < 4; ++e) { v0[e] = v0[e] * sigm(v0[e]); v1[e] = v1[e] * sigm(v1[e]); } }
                        *(u32x4e*)(rowp + bj * HALF) = pack8(v0, v1); } }
        } else if (pn < 24) {
            const int colt = (pn - 16) * 128 + x0;
#pragma unroll
            for (int ai = 0; ai < 2; ++ai)
#pragma unroll
                for (int m = 0; m < 4; ++m) { bf16_t* rowp = (bf16_t*)(ws + WS_BOG) + (size_t)(row0 + ai * HALF + m * 16) * 1024 + colt;
                    f32x4 v0, v1;
#pragma unroll
                    for (int e = 0; e < 4; ++e) { const float o0 = acc[ai][0][m][0][e], z0 = acc[ai][1][m][0][e], o1 = acc[ai][0][m][1][e], z1 = acc[ai][1][m][1][e];
                        v0[e] = sigm(o0) * z0 * sigm(z0); v1[e] = sigm(o1) * z1 * sigm(z1); }
                    *(u32x4e*)(rowp) = pack8(v0, v1); }
        } else if (pn < 32) {
            bf16_t* O = (bf16_t*)(ws + (pn < 28 ? WS_SGA : WS_SGB)); const int colt = (pn & 3) * 256 + x0;
#pragma unroll
            for (int ai = 0; ai < 2; ++ai)
#pragma unroll
                for (int m = 0; m < 4; ++m) { bf16_t* rowp = O + (size_t)(row0 + ai * HALF + m * 16) * 1024 + colt;
#pragma unroll
                    for (int bj = 0; bj < 2; ++bj) { f32x4 v0 = acc[ai][bj][m][0], v1 = acc[ai][bj][m][1];
#pragma unroll
                        for (int e = 0; e < 4; ++e) { v0[e] = sigm(v0[e]); v1[e] = sigm(v1[e]); }
                        *(u32x4e*)(rowp + bj * HALF) = pack8(v0, v1); } }
        } else {
            if (wc == 0 && fq < 2) {
#pragma unroll
                for (int ai = 0; ai < 2; ++ai)
#pragma unroll
                    for (int m = 0; m < 4; ++m) { float* rowp = (float*)(ws + WS_GATES) + (size_t)(row0 + ai * HALF + m * 16) * 16 + 8 * fq;
                        *(f32x4*)(rowp) = acc[ai][0][m][0]; *(f32x4*)(rowp + 4) = acc[ai][0][m][1]; }
            }
        }
    }
};

struct EpiOutA {
    static constexpr bool PERM = true, AFTER_DRAIN = false;
    bf16_t* U; const bf16_t* G;
    __device__ __forceinline__ void operator()(const f32x4 (&acc)[2][2][4][2], const Unit& u, int wr, int wc, int fr, int fq) const {
        const int row0 = u.pm * BM + wr * 64 + fr, col0 = u.pn * BM + wc * 32 + 8 * fq;
#pragma unroll
        for (int ai = 0; ai < 2; ++ai)
#pragma unroll
            for (int m = 0; m < 4; ++m) { const size_t off = (size_t)(row0 + ai * HALF + m * 16) * 1024 + col0;
#pragma unroll
                for (int bj = 0; bj < 2; ++bj) { f32x4 g0, g1; unpack8(*(const u32x4e*)(G + off + bj * HALF), g0, g1);
                    *(u32x4e*)(U + off + bj * HALF) = pack8(acc[ai][bj][m][0] * g0, acc[ai][bj][m][1] * g1); } asm volatile("" ::: "memory"); }
    }
};
struct EpiOutB {
    static constexpr bool PERM = true, AFTER_DRAIN = false;
    bf16_t* U; const bf16_t* G;
    __device__ __forceinline__ void operator()(const f32x4 (&acc)[2][2][4][2], const Unit& u, int wr, int wc, int fr, int fq) const {
        const int row0 = u.pm * BM + wr * 64 + fr, col0 = u.pn * BM + wc * 32 + 8 * fq;
#pragma unroll
        for (int ai = 0; ai < 2; ++ai)
#pragma unroll
            for (int m = 0; m < 4; ++m) { const size_t off = (size_t)(row0 + ai * HALF + m * 16) * 1024 + col0;
#pragma unroll
                for (int bj = 0; bj < 2; ++bj) { f32x4 g0, g1, p0, p1; unpack8(*(const u32x4e*)(G + off + bj * HALF), g0, g1); unpack8(*(const u32x4e*)(U + off + bj * HALF), p0, p1);
                    *(u32x4e*)(U + off + bj * HALF) = pack8(p0 + acc[ai][bj][m][0] * g0, p1 + acc[ai][bj][m][1] * g1); } asm volatile("" ::: "memory"); }
    }
};
struct EpiFinal {
    static constexpr bool PERM = true, AFTER_DRAIN = false;
    const float* base; float* out;
    __device__ __forceinline__ void operator()(const f32x4 (&acc)[2][2][4][2], const Unit& u, int wr, int wc, int fr, int fq) const {
        const int row0 = u.pm * BM + wr * 64 + fr, col0 = u.pn * BM + wc * 32 + 8 * fq;
#pragma unroll
        for (int ai = 0; ai < 2; ++ai)
#pragma unroll
            for (int m = 0; m < 4; ++m) { const size_t off = (size_t)(row0 + ai * HALF + m * 16) * 1024 + col0;
#pragma unroll
                for (int bj = 0; bj < 2; ++bj) { const f32x4 b0 = *(const f32x4*)(base + off + bj * HALF), b1 = *(const f32x4*)(base + off + bj * HALF + 4);
                    *(f32x4*)(out + off + bj * HALF) = b0 + acc[ai][bj][m][0]; *(f32x4*)(out + off + bj * HALF + 4) = b1 + acc[ai][bj][m][1]; } asm volatile("" ::: "memory"); }
    }
};

template <class Epi, class Sched, bool ALIGN_EPI = false, bool SP2 = false>
__device__ __forceinline__ void gemm_phase(PG8_LAS unsigned char* lds, const Gemm g, const Sched& S, const Epi& E) {
    int tid_l = threadIdx.x; asm volatile("" : "+v"(tid_l));
    const int tid = tid_l, wid = __builtin_amdgcn_readfirstlane(tid >> 6), lane = tid & 63, wr = wid >> 2, wc = wid & 3, fr = lane & 15, fq = lane >> 4;
    const int K = g.K, nt = K / BK;
    unsigned voffA[2], voffB[2];
#pragma unroll
    for (int i = 0; i < 2; ++i) { int R, C; stage_rc(tid * 16 + i * 8192, R, C); const int Rb = Epi::PERM ? ((R & ~31) + perm32(R & 31)) : R;
        voffA[i] = (unsigned)(R * K + C) * 2u; voffB[i] = (unsigned)(Rb * K + C) * 2u; }
    const size_t kstep = (size_t)(BK * 2);
    const size_t hstep = (size_t)HALF * K * 2;
    const size_t tstep = 2 * hstep;
    const unsigned ldsw = (unsigned)wid * 1024u;
    const int aoff = lds_byte(wr * 64 + fr, fq * 8), boff = lds_byte(wc * 32 + fr, fq * 8);
#define PG8_SA(b, h) (((b) * 2 + (h)) * HTB)
#define PG8_SB(b, h) ((4 + (b) * 2 + (h)) * HTB)
#define PG8_STAGE(bufoff, gbase, voff) do { _Pragma("unroll") for (int _i = 0; _i < 2; ++_i) \
        __builtin_amdgcn_global_load_lds((const unsigned*)((const char*)(gbase) + (voff)[_i]), (PG8_LAS unsigned*)(lds + (bufoff) + ldsw + _i * 8192), 16, 0, 0); } while (0)
#define PG8_LDA(dst, b, h) do { _Pragma("unroll") for (int m = 0; m < 4; ++m) _Pragma("unroll") for (int k = 0; k < 2; ++k) dst[m][k] = *(const PG8_LAS bf16x8*)(lds + PG8_SA(b, h) + aoff + m * 2048 + k * 1024); } while (0)
#define PG8_LDB(dst, b, h) do { _Pragma("unroll") for (int n = 0; n < 2; ++n) _Pragma("unroll") for (int k = 0; k < 2; ++k) dst[n][k] = *(const PG8_LAS bf16x8*)(lds + PG8_SB(b, h) + boff + n * 2048 + k * 1024); } while (0)
#define PG8_MMA(ai, bj, At, Bt) do { __builtin_amdgcn_s_setprio(1); _Pragma("unroll") for (int m = 0; m < 4; ++m) _Pragma("unroll") for (int n = 0; n < 2; ++n) _Pragma("unroll") for (int k = 0; k < 2; ++k) \
        acc[ai][bj][m][n] = __builtin_amdgcn_mfma_f32_16x16x32_bf16(Bt[n][k], At[m][k], acc[ai][bj][m][n], 0, 0, 0); __builtin_amdgcn_s_setprio(0); } while (0)
#define PG8_WAIT_V(n) asm volatile("s_waitcnt vmcnt(" #n ")" ::: "memory")
#define PG8_WAIT_L(n) asm volatile("s_waitcnt lgkmcnt(" #n ")" ::: "memory")
#define PG8_BAR __builtin_amdgcn_s_barrier()
#define PG8_SCHED __builtin_amdgcn_sched_barrier(0)
    Unit cur, nxt; int ui = 0;
    if (!S.next(0, cur)) return;
    f32x4 acc[2][2][4][2];
#pragma unroll
    for (int a = 0; a < 2; ++a)
#pragma unroll
        for (int b = 0; b < 2; ++b)
#pragma unroll
            for (int m = 0; m < 4; ++m)
#pragma unroll
                for (int n = 0; n < 2; ++n) acc[a][b][m][n] = (f32x4){0.f, 0.f, 0.f, 0.f};
    bf16x8 At[4][2], B0[2][2], B1[2][2];
    const char* cA = (const char*)g.A + (size_t)cur.pm * tstep; const char* cB = (const char*)g.Bt + (size_t)cur.pn * tstep;
    S.a_ready(cur);
    if constexpr (SP2) {
        PG8_STAGE(PG8_SB(0, 0), cB, voffB); PG8_STAGE(PG8_SB(0, 1), cB + hstep, voffB); PG8_STAGE(PG8_SA(0, 0), cA, voffA); PG8_STAGE(PG8_SA(0, 1), cA + hstep, voffA);
        if (wr == 1) PG8_BAR;
        PG8_WAIT_V(2); PG8_BAR;
        PG8_STAGE(PG8_SB(1, 0), cB + kstep, voffB); PG8_STAGE(PG8_SA(1, 0), cA + kstep, voffA); PG8_STAGE(PG8_SB(1, 1), cB + hstep + kstep, voffB);
        PG8_WAIT_V(6); PG8_BAR;
    } else {
        PG8_STAGE(PG8_SB(0, 0), cB, voffB); PG8_STAGE(PG8_SA(0, 0), cA, voffA); PG8_STAGE(PG8_SB(0, 1), cB + hstep, voffB); PG8_STAGE(PG8_SA(0, 1), cA + hstep, voffA);
        if (wr == 1) PG8_BAR;
        PG8_WAIT_V(4); PG8_BAR;
        PG8_STAGE(PG8_SB(1, 0), cB + kstep, voffB); PG8_STAGE(PG8_SA(1, 0), cA + kstep, voffA); PG8_STAGE(PG8_SB(1, 1), cB + hstep + kstep, voffB);
        PG8_WAIT_V(6); PG8_BAR;
    }
    for (;;) {
        const bool has_next = S.next(ui + 1, nxt);
        const char* nA = has_next ? (const char*)g.A + (size_t)nxt.pm * tstep : cA; const char* nB = has_next ? (const char*)g.Bt + (size_t)nxt.pn * tstep : cB;
        for (int t = 0; t < nt; t += 2) {
            const bool last = (t == nt - 2);
            const char* a1 = cA + (size_t)(t + 1) * kstep;
            const char* a2 = last ? nA : cA + (size_t)(t + 2) * kstep; const char* b2 = last ? nB : cB + (size_t)(t + 2) * kstep;
            const char* a3 = a2 + kstep; const char* b3 = b2 + kstep;
            if (last && has_next) S.a_ready(nxt);
            if constexpr (SP2) {
            PG8_LDB(B0, 0, 0); PG8_LDB(B1, 0, 1); PG8_SCHED; PG8_LDA(At, 0, 0); PG8_STAGE(PG8_SA(1, 1), a1 + hstep, voffA);
            PG8_WAIT_V(8); PG8_WAIT_L(0); PG8_BAR; PG8_MMA(0, 0, At, B0); PG8_MMA(0, 1, At, B1); PG8_BAR; PG8_SCHED;
            PG8_LDA(At, 0, 1); PG8_STAGE(PG8_SB(0, 0), b2, voffB); PG8_STAGE(PG8_SB(0, 1), b2 + hstep, voffB); PG8_STAGE(PG8_SA(0, 0), a2, voffA);
            PG8_WAIT_V(8); PG8_WAIT_L(0); PG8_BAR; PG8_MMA(1, 0, At, B0); PG8_MMA(1, 1, At, B1); PG8_BAR; PG8_SCHED;
            PG8_LDB(B0, 1, 0); PG8_LDB(B1, 1, 1); PG8_SCHED; PG8_LDA(At, 1, 0); PG8_STAGE(PG8_SA(0, 1), a2 + hstep, voffA);
            PG8_WAIT_V(8); PG8_WAIT_L(0); PG8_BAR; PG8_MMA(0, 0, At, B0); PG8_MMA(0, 1, At, B1); PG8_BAR; PG8_SCHED;
            PG8_LDA(At, 1, 1); PG8_STAGE(PG8_SB(1, 0), b3, voffB); PG8_STAGE(PG8_SB(1, 1), b3 + hstep, voffB); PG8_STAGE(PG8_SA(1, 0), a3, voffA);
            PG8_WAIT_V(8); PG8_WAIT_L(0); PG8_BAR; PG8_MMA(1, 0, At, B0); PG8_MMA(1, 1, At, B1); PG8_BAR; PG8_SCHED;
            } else {
            PG8_LDB(B0, 0, 0); PG8_SCHED; PG8_LDA(At, 0, 0); PG8_STAGE(PG8_SA(1, 1), a1 + hstep, voffA);
            PG8_WAIT_L(8); PG8_BAR; PG8_WAIT_L(0); PG8_MMA(0, 0, At, B0); PG8_BAR; PG8_SCHED;
            PG8_LDB(B1, 0, 1); PG8_STAGE(PG8_SB(0, 0), b2, voffB);
            PG8_BAR; PG8_WAIT_L(0); PG8_MMA(0, 1, At, B1); PG8_BAR;
            PG8_LDA(At, 0, 1); PG8_STAGE(PG8_SA(0, 0), a2, voffA);
            PG8_BAR; PG8_WAIT_L(0); PG8_MMA(1, 0, At, B0); PG8_BAR; PG8_SCHED;
            PG8_STAGE(PG8_SB(0, 1), b2 + hstep, voffB);
            PG8_WAIT_V(6); PG8_BAR; PG8_MMA(1, 1, At, B1); PG8_BAR;
            PG8_LDB(B0, 1, 0); PG8_SCHED; PG8_LDA(At, 1, 0); PG8_STAGE(PG8_SA(0, 1), a2 + hstep, voffA);
            PG8_WAIT_L(8); PG8_BAR; PG8_WAIT_L(0); PG8_MMA(0, 0, At, B0); PG8_BAR; PG8_SCHED;
            PG8_LDB(B1, 1, 1); PG8_STAGE(PG8_SB(1, 0), b3, voffB);
            PG8_BAR; PG8_WAIT_L(0); PG8_MMA(0, 1, At, B1); PG8_BAR;
            PG8_LDA(At, 1, 1); PG8_STAGE(PG8_SA(1, 0), a3, voffA);
            PG8_BAR; PG8_WAIT_L(0); PG8_MMA(1, 0, At, B0); PG8_BAR; PG8_SCHED;
            PG8_STAGE(PG8_SB(1, 1), b3 + hstep, voffB);
            PG8_WAIT_V(6); PG8_BAR; PG8_MMA(1, 1, At, B1); PG8_BAR;
            }
        }
        if constexpr (ALIGN_EPI) { if (wr == 0) PG8_BAR; }
        if constexpr (!Epi::AFTER_DRAIN) { E(acc, cur, wr, wc, fr, fq); S.done(cur); }
        if (!has_next) break;
#pragma unroll
        for (int a = 0; a < 2; ++a)
#pragma unroll
            for (int b = 0; b < 2; ++b)
#pragma unroll
                for (int m = 0; m < 4; ++m)
#pragma unroll
                    for (int n = 0; n < 2; ++n) acc[a][b][m][n] = (f32x4){0.f, 0.f, 0.f, 0.f};
        cur = nxt; cA = nA; cB = nB; ++ui;
        if constexpr (ALIGN_EPI) { if (wr == 1) PG8_BAR; }
    }
    PG8_WAIT_V(0);
    if constexpr (!ALIGN_EPI) { if (wr == 0) PG8_BAR; }
    PG8_BAR;
    if constexpr (Epi::AFTER_DRAIN) { E.fused(acc, cur, wr, wc, fr, fq, lds, wid, lane); S.done(cur); }
#undef PG8_SA
#undef PG8_SB
#undef PG8_STAGE
#undef PG8_LDA
#undef PG8_LDB
#undef PG8_MMA
#undef PG8_WAIT_V
#undef PG8_WAIT_L
#undef PG8_BAR
#undef PG8_SCHED
}
}
#include <hip/hip_cooperative_groups.h>
namespace cg = cooperative_groups;
#define LAS __attribute__((address_space(3)))
typedef unsigned short bf16;
typedef float f32x4 __attribute__((ext_vector_type(4)));
typedef float f32x16 __attribute__((ext_vector_type(16)));
typedef short bf16x8 __attribute__((ext_vector_type(8)));
typedef unsigned u32x4 __attribute__((ext_vector_type(4)));
typedef unsigned u32x2 __attribute__((ext_vector_type(2)));

constexpr int LDS_BYTES = 147456;

struct Params {
    const float* in[16]; float* out; unsigned char* ws; float inv_freq[32]; float lam_init[2]; int pad[2];
};

__device__ __forceinline__ unsigned f2bf(float f) { unsigned u = __builtin_bit_cast(unsigned, f); return (u + 0x7fffu + ((u >> 16) & 1u)) >> 16; }
__device__ __forceinline__ unsigned pk2(float lo, float hi) { return pg8::cvt_pk_bf16(lo, hi); }
__device__ __forceinline__ float bflo(unsigned w) { return __uint_as_float(w << 16); }
__device__ __forceinline__ float bfhi(unsigned w) { return __uint_as_float(w & 0xffff0000u); }
__device__ __forceinline__ float wave_sum(float v) {
    int l = (int)__builtin_amdgcn_mbcnt_hi(~0u, __builtin_amdgcn_mbcnt_lo(~0u, 0u)); asm volatile("" : "+v"(l));
#pragma unroll
    for (int o = 1; o < 64; o <<= 1) v += __uint_as_float((unsigned)__builtin_amdgcn_ds_bpermute((l ^ o) << 2, (int)__float_as_uint(v)));
    return v;
}
__device__ __forceinline__ float wave_max(float v) {
    int l = (int)__builtin_amdgcn_mbcnt_hi(~0u, __builtin_amdgcn_mbcnt_lo(~0u, 0u)); asm volatile("" : "+v"(l));
#pragma unroll
    for (int o = 1; o < 64; o <<= 1) v = fmaxf(v, __uint_as_float((unsigned)__builtin_amdgcn_ds_bpermute((l ^ o) << 2, (int)__float_as_uint(v))));
    return v;
}
__device__ __forceinline__ float sigm(float x) { return __builtin_amdgcn_rcpf(1.0f + __expf(-x)); }

typedef const __attribute__((address_space(4))) Params* KParams;
__device__ __forceinline__ int win_logical(int pb, int& valid) {
    const int p = pb * 32; valid = 32;
    if (p < 2048) { const int sec = p >> 10, pp = p & 1023, tile = pp >> 8, x = pp & 255, bj = x >> 7, wc = (x & 127) >> 5; return sec * 1024 + tile * 256 + 64 * wc + 32 * bj; }
    if (p < 3072) return 3072 + (p - 2048);
    if (p < 4096) return 4096 + (p - 3072);
    if (p < 6144) { const int pp = p - 4096, j = pp >> 8, x = pp & 255, bj = x >> 7, xx = x & 127; return (bj == 0 ? 6160 : 7184) + 128 * j + xx; }
    if (p < 7168) return 8208 + (p - 6144);
    if (p < 8192) return 9232 + (p - 7168);
    if (p < 8448) { if (p == 8192) { valid = 16; return 6144; } valid = 0; return 0; }
    if (p < 9472) return 2048 + (p - 8448);
    return 5120 + (p - 9472);
}
__device__ __forceinline__ void transpose_item(const float* W, int N, int lc, int valid, bf16* WT, int prow0, int k0, LAS float* scr, int lane) {
#pragma unroll 8
    for (int i = 0; i < 32; ++i) { const int kk = 2 * i + (lane >> 5), c = lane & 31; scr[kk * 33 + c] = (c < valid) ? W[(size_t)(k0 + kk) * N + lc + c] : 0.f; }
    asm volatile("s_waitcnt lgkmcnt(0)" ::: "memory");
    const int c = lane & 7;
#pragma unroll
    for (int j = 0; j < 4; ++j) { const int n = (lane >> 3) + 8 * j; const LAS float* s = scr + (8 * c) * 33 + n;
        u32x4 o; o.x = pk2(s[0 * 33], s[1 * 33]); o.y = pk2(s[2 * 33], s[3 * 33]); o.z = pk2(s[4 * 33], s[5 * 33]); o.w = pk2(s[6 * 33], s[7 * 33]);
        *(u32x4*)(WT + (size_t)(prow0 + n) * 1024 + k0 + 8 * c) = o; }
    asm volatile("s_waitcnt lgkmcnt(0)" ::: "memory");
}
__device__ __forceinline__ void sincos_d(double r, double& s, double& c) {
    const double r2 = r * r; double ss = 1.0, cc = 1.0;
#pragma unroll
    for (int n = 14; n >= 1; --n) { ss = 1.0 - ss * r2 * (1.0 / (double)((2 * n) * (2 * n + 1))); cc = 1.0 - cc * r2 * (1.0 / (double)((2 * n - 1) * (2 * n))); }
    s = r * ss; c = cc;
}
__device__ __forceinline__ void prologue(KParams P, LAS unsigned char* lds, int wave, int lane) {
    LAS float* scr = (LAS float*)(lds + wave * 16384);
    const int gw = blockIdx.x * 8 + wave, NGW = gridDim.x * 8;
    constexpr int PB = WT_ROWS / 32, I_IN = PB * 16, I_SQ = 32 * 16;
    constexpr int NITEMS = NLAYER * (I_IN + 3 * I_SQ);
    for (int it = gw; it < NITEMS; it += NGW) {
        const int l = it / (I_IN + 3 * I_SQ); int r = it % (I_IN + 3 * I_SQ);
        if (r < I_IN) { const int pb = r >> 4, kb = r & 15; int valid; const int lc = win_logical(pb, valid);
            transpose_item(P->in[3] + (size_t)l * 1024 * DIN, DIN, lc, valid, (bf16*)(P->ws + WS_WTIN) + (size_t)l * WT_ROWS * 1024, pb * 32, kb * 64, scr, lane); continue; }
        r -= I_IN; const int which = r / I_SQ; r %= I_SQ; const int pb = r >> 4, kb = r & 15;
        const float* W = (which == 0 ? P->in[8] : which == 1 ? P->in[14] : P->in[15]) + (size_t)l * 1024 * 1024;
        bf16* WT = (bf16*)(P->ws + (which == 0 ? WS_WTOA : which == 1 ? WS_WTOB : WS_WTO)) + (size_t)l * 1024 * 1024;
        transpose_item(W, 1024, pb * 32, 32, WT, pb * 32, kb * 64, scr, lane);
    }
    const int* pos = (const int*)P->in[1]; float* cosT = (float*)(P->ws + WS_COS); float* sinT = (float*)(P->ws + WS_SIN);
    int t_l = threadIdx.x; asm volatile("" : "+v"(t_l)); const int gt = blockIdx.x * 512 + t_l, NT = gridDim.x * 512;
    for (int i = gt; i < NTOK * 32; i += NT) {
        const float ang = (float)pos[i >> 5] * P->inv_freq[i & 31];
        const double a = (double)ang; const double k = __builtin_rint(a * 0.15915494309189535); const double r = a - k * 6.283185307179586476925;
        double s, c; sincos_d(r, s, c); cosT[i] = (float)c; sinT[i] = (float)s;
    }
}
__device__ __forceinline__ void rmsnorm_phase(const float* xin, const float* g, bf16* H, int wave, int lane) {
    asm volatile("" : "+v"(lane));
    const int gw = blockIdx.x * 8 + wave, NGW = gridDim.x * 8;
    f32x4 gv[4];
#pragma unroll
    for (int j = 0; j < 4; ++j) gv[j] = *((const f32x4*)g + lane + 64 * j);
    f32x4 vn[4];
    if (gw < TH) { const f32x4* xr0 = (const f32x4*)(xin + (size_t)gw * DM) + lane;
#pragma unroll
        for (int j = 0; j < 4; ++j) vn[j] = xr0[64 * j]; }
    for (int m = gw; m < TH; m += NGW) {
        f32x4 v[4]; float s = 0.f;
#pragma unroll
        for (int j = 0; j < 4; ++j) v[j] = vn[j];
        if (m + NGW < TH) { const f32x4* xr1 = (const f32x4*)(xin + (size_t)(m + NGW) * DM) + lane;
#pragma unroll
            for (int j = 0; j < 4; ++j) vn[j] = xr1[64 * j]; }
#pragma unroll
        for (int j = 0; j < 4; ++j) s += (v[j].x * v[j].x + v[j].y * v[j].y) + (v[j].z * v[j].z + v[j].w * v[j].w);
        const float rs = rsqrtf(wave_sum(s) * (1.0f / DM) + EPS);
        u32x2* o8 = (u32x2*)(H + (size_t)m * DM) + lane;
#pragma unroll
        for (int j = 0; j < 4; ++j) { u32x2 w; w.x = pk2(v[j].x * rs * gv[j].x, v[j].y * rs * gv[j].y); w.y = pk2(v[j].z * rs * gv[j].z, v[j].w * rs * gv[j].w); o8[64 * j] = w; }
    }
}

__device__ __forceinline__ void gates_phase(const bf16* H, const bf16* WTg, float* GATES) {
    int t_l = threadIdx.x; asm volatile("" : "+v"(t_l));
    const int lane = t_l & 63, fr = lane & 15, fq = lane >> 4, gw = blockIdx.x * 8 + (t_l >> 6), NGW = gridDim.x * 8;
    for (int task = gw; task < TH / 16; task += NGW) {
        const bf16* ap = H + (size_t)(task * 16 + fr) * 1024 + 8 * fq; const bf16* bp = WTg + (size_t)fr * 1024 + 8 * fq;
        f32x4 acc = {0.f, 0.f, 0.f, 0.f};
#pragma unroll 8
        for (int k0 = 0; k0 < 1024; k0 += 32) acc = __builtin_amdgcn_mfma_f32_16x16x32_bf16(*(const bf16x8*)(ap + k0), *(const bf16x8*)(bp + k0), acc, 0, 0, 0);
#pragma unroll
        for (int i = 0; i < 4; ++i) GATES[(size_t)(task * 16 + 4 * fq + i) * 16 + fr] = acc[i];
    }
}
constexpr int AK_STRIDE = 72, AV_STRIDE = 72;
constexpr int AK_BYTES = 64 * AK_STRIDE * 2, AV_BYTES = 128 * AV_STRIDE * 2;
__device__ __forceinline__ int crow(int r, int hi) { return (r & 3) + 8 * (r >> 2) + 4 * hi; }
#define ATT_BAR() do { asm volatile("s_waitcnt lgkmcnt(0)" ::: "memory"); __builtin_amdgcn_s_barrier(); asm volatile("" ::: "memory"); } while (0)
__device__ __forceinline__ void attn_unit(LAS unsigned char* lds, const bf16* Q, bf16* Oo, const bf16* K, const bf16* VT, const bf16* SAZ, const float* ang, float lam, float outscale, float negshift, int bl, int h, int qb) {
    int tid_l = threadIdx.x; asm volatile("" : "+v"(tid_l));
    const int tid = tid_l, lane = tid & 63, r32 = lane & 31, hi = lane >> 5; const int wid = __builtin_amdgcn_readfirstlane(tid >> 6);
    const size_t tok0 = (size_t)bl * SEQ; const int q0 = qb * 256 + wid * 32;
    LAS bf16* Ks = (LAS bf16*)lds; LAS bf16* Vs = (LAS bf16*)(lds + 2 * AK_BYTES);
    const int NT = 4 * (qb + 1);
    const LAS bf16* ksl = Ks + r32 * AK_STRIDE + hi * 8; const LAS bf16* vsl = Vs + r32 * AV_STRIDE + hi * 8;
    LAS unsigned* o0s = (LAS unsigned*)(lds + 57344) + wid * 2048 + lane;
    const int krow_s = tid >> 3, kch = tid & 7;
    const int vpos0 = ((kch >> 1) * 4 + ((kch & 1) ? 1 : 0)) * 4, vpos1 = ((kch >> 1) * 4 + ((kch & 1) ? 3 : 2)) * 4;
#pragma unroll 1
    for (int r = 0; r < 2; ++r) {
        const bf16* Qp = Q + (tok0 + q0 + r32) * 1024 + (h * 2 + r) * 64;
        bf16x8 qr[4];
#pragma unroll
        for (int d0 = 0; d0 < 4; ++d0) qr[d0] = *(const bf16x8*)(Qp + d0 * 16 + hi * 8);
        asm volatile("" : "+v"(qr[0]), "+v"(qr[1]), "+v"(qr[2]), "+v"(qr[3]));
        const bf16* Kub = K + tok0 * 1024 + (h * 2 + r) * 64; const bf16* Vub = VT + (size_t)(h * 128) * TH + tok0;
        const unsigned klo = (unsigned)(krow_s * 1024 + kch * 8) * 2u, vlo = (unsigned)((tid >> 3) * TH + kch * 8) * 2u;
#define ATT_LDG(UB, OFF) ({ const bf16* ub_ = (UB); asm volatile("" : "+s"(ub_)); *(const u32x4*)((const char*)ub_ + (OFF)); })
        u32x4 kreg = ATT_LDG(Kub, klo), v0reg = ATT_LDG(Kub + (size_t)64 * 1024, klo), v1reg;
        *(LAS u32x4*)(Ks + krow_s * AK_STRIDE + kch * 8) = kreg;
        *(LAS u32x4*)(Ks + 64 * AK_STRIDE + krow_s * AK_STRIDE + kch * 8) = v0reg;
        ATT_BAR();
        f32x16 o[4];
#pragma unroll
        for (int b = 0; b < 4; ++b)
#pragma unroll
            for (int i = 0; i < 16; ++i) o[b][i] = 0.f;
        float lrun = 0.f;
        const int qg = q0 + r32;
        const int wlast = (q0 + 31) >> 6;
        f32x16 p0, p1; bf16x8 pf[4];
#pragma unroll
        for (int s = 0; s < 4; ++s) pf[s] = (bf16x8){0, 0, 0, 0, 0, 0, 0, 0};
#define ATT_QK(KS) do { const LAS bf16* ks_ = (KS); bf16x8 kf[8]; const f32x16 zc = {0.f, 0.f, 0.f, 0.f, 0.f, 0.f, 0.f, 0.f, 0.f, 0.f, 0.f, 0.f, 0.f, 0.f, 0.f, 0.f}; \
        _Pragma("unroll") for (int d0 = 0; d0 < 4; ++d0) { kf[2 * d0] = *(const LAS bf16x8*)(ks_ + d0 * 16); kf[2 * d0 + 1] = *(const LAS bf16x8*)(ks_ + 32 * AK_STRIDE + d0 * 16); } \
        p0 = __builtin_amdgcn_mfma_f32_32x32x16_bf16(kf[0], qr[0], zc, 0, 0, 0); p1 = __builtin_amdgcn_mfma_f32_32x32x16_bf16(kf[1], qr[0], zc, 0, 0, 0); \
        _Pragma("unroll") for (int d0 = 1; d0 < 4; ++d0) { p0 = __builtin_amdgcn_mfma_f32_32x32x16_bf16(kf[2 * d0], qr[d0], p0, 0, 0, 0); p1 = __builtin_amdgcn_mfma_f32_32x32x16_bf16(kf[2 * d0 + 1], qr[d0], p1, 0, 0, 0); } } while (0)
#define ATT_MASK(T) do { if (negshift != 0.f) { _Pragma("unroll") for (int i = 0; i < 16; ++i) { p0[i] += negshift; p1[i] += negshift; } } \
        if (64 * (T) + 63 > q0) { _Pragma("unroll") for (int i = 0; i < 16; ++i) { const int kv = 64 * (T) + crow(i, hi); if (kv > qg) p0[i] = -INFINITY; if (kv + 32 > qg) p1[i] = -INFINITY; } } } while (0)
#define ATT_SM1(P, B, DST) do { float s_ = 0.f; _Pragma("unroll") for (int i = 0; i < 8; ++i) { P[(B) + i] = __builtin_amdgcn_exp2f(P[(B) + i]); s_ += P[(B) + i]; } lrun += s_; u32x4 w_; \
        w_.x = pk2(P[(B)], P[(B) + 1]); w_.y = pk2(P[(B) + 2], P[(B) + 3]); w_.z = pk2(P[(B) + 4], P[(B) + 5]); w_.w = pk2(P[(B) + 6], P[(B) + 7]); DST = __builtin_bit_cast(bf16x8, w_); } while (0)
#define ATT_SM(PFN) do { ATT_SM1(p0, 0, PFN[0]); ATT_SM1(p0, 8, PFN[1]); ATT_SM1(p1, 0, PFN[2]); ATT_SM1(p1, 8, PFN[3]); } while (0)
#define ATT_PVL(VS) const LAS bf16* vs_ = (VS); bf16x8 vfa[4], vfb[4]; \
        _Pragma("unroll") for (int bb = 0; bb < 4; ++bb) vfa[bb] = *(const LAS bf16x8*)(vs_ + 32 * bb * AV_STRIDE);
#define ATT_PVM() do { \
        _Pragma("unroll") for (int bb = 0; bb < 4; ++bb) vfb[bb] = *(const LAS bf16x8*)(vs_ + 32 * bb * AV_STRIDE + 16); \
        _Pragma("unroll") for (int bb = 0; bb < 4; ++bb) o[bb] = __builtin_amdgcn_mfma_f32_32x32x16_bf16(vfa[bb], pf[0], o[bb], 0, 0, 0); \
        _Pragma("unroll") for (int bb = 0; bb < 4; ++bb) vfa[bb] = *(const LAS bf16x8*)(vs_ + 32 * bb * AV_STRIDE + 32); \
        _Pragma("unroll") for (int bb = 0; bb < 4; ++bb) o[bb] = __builtin_amdgcn_mfma_f32_32x32x16_bf16(vfb[bb], pf[1], o[bb], 0, 0, 0); \
        _Pragma("unroll") for (int bb = 0; bb < 4; ++bb) vfb[bb] = *(const LAS bf16x8*)(vs_ + 32 * bb * AV_STRIDE + 48); \
        _Pragma("unroll") for (int bb = 0; bb < 4; ++bb) o[bb] = __builtin_amdgcn_mfma_f32_32x32x16_bf16(vfa[bb], pf[2], o[bb], 0, 0, 0); \
        _Pragma("unroll") for (int bb = 0; bb < 4; ++bb) o[bb] = __builtin_amdgcn_mfma_f32_32x32x16_bf16(vfb[bb], pf[3], o[bb], 0, 0, 0); } while (0)
        ATT_QK(ksl);
        ATT_BAR();
#define ATT_STAGE_LD(T) do { v0reg = ATT_LDG(Vub + (T) * 64, vlo); v1reg = ATT_LDG(Vub + (size_t)64 * TH + (T) * 64, vlo); if ((T) + 2 < NT) kreg = ATT_LDG(Kub + (size_t)((T) + 2) * 64 * 1024, klo); } while (0)
#define ATT_STAGE_ST(T) do { LAS bf16* vd = Vs + ((T) & 1) * 128 * AV_STRIDE + (tid >> 3) * AV_STRIDE; \
        *(LAS u32x2*)(vd + vpos0) = (u32x2){v0reg.x, v0reg.y}; *(LAS u32x2*)(vd + vpos1) = (u32x2){v0reg.z, v0reg.w}; vd += 64 * AV_STRIDE; \
        *(LAS u32x2*)(vd + vpos0) = (u32x2){v1reg.x, v1reg.y}; *(LAS u32x2*)(vd + vpos1) = (u32x2){v1reg.z, v1reg.w}; \
        if ((T) + 2 < NT) *(LAS u32x4*)(Ks + ((T) & 1) * 64 * AK_STRIDE + krow_s * AK_STRIDE + kch * 8) = kreg; } while (0)
        {
            ATT_STAGE_LD(0);
            ATT_MASK(0); ATT_SM(pf);
            if (1 <= wlast) ATT_QK(ksl + 64 * AK_STRIDE);
            ATT_STAGE_ST(0);
            ATT_BAR();
        }
        const int tend = wlast < NT - 1 ? wlast : NT - 1;
#pragma unroll 1
        for (int t = 1; t <= tend; ++t) {
            {
                const int kt = (t + 2 < NT) ? t + 2 : NT - 1;
                v0reg = ATT_LDG(Vub + t * 64, vlo); v1reg = ATT_LDG(Vub + (size_t)64 * TH + t * 64, vlo); kreg = ATT_LDG(Kub + (size_t)kt * 64 * 1024, klo);
            }
            {
                bf16x8 pfn[4];
                ATT_PVL(vsl + ((t - 1) & 1) * 128 * AV_STRIDE)
                ATT_MASK(t);
                ATT_PVM();
                ATT_SM(pfn);
#pragma unroll
                for (int i = 0; i < 16; ++i) { __builtin_amdgcn_sched_group_barrier(0x008, 1, 0); __builtin_amdgcn_sched_group_barrier(0x400, 2, 0); __builtin_amdgcn_sched_group_barrier(0x002, 3, 0); }
#pragma unroll
                for (int s = 0; s < 4; ++s) pf[s] = pfn[s];
            }
            ATT_QK(ksl + ((t + 1) & 1) * 64 * AK_STRIDE);
            {
                LAS bf16* vd = Vs + (t & 1) * 128 * AV_STRIDE + (tid >> 3) * AV_STRIDE;
                *(LAS u32x2*)(vd + vpos0) = (u32x2){v0reg.x, v0reg.y}; *(LAS u32x2*)(vd + vpos1) = (u32x2){v0reg.z, v0reg.w}; vd += 64 * AV_STRIDE;
                *(LAS u32x2*)(vd + vpos0) = (u32x2){v1reg.x, v1reg.y}; *(LAS u32x2*)(vd + vpos1) = (u32x2){v1reg.z, v1reg.w};
                *(LAS u32x4*)(Ks + (t & 1) * 64 * AK_STRIDE + krow_s * AK_STRIDE + kch * 8) = kreg;
            }
            ATT_BAR();
        }
        if (tend < NT - 1) {
            ATT_STAGE_LD(tend + 1);
            { ATT_PVL(vsl + (tend & 1) * 128 * AV_STRIDE) ATT_PVM(); }
            ATT_STAGE_ST(tend + 1);
            ATT_BAR();
#pragma unroll 1
            for (int t = tend + 2; t < NT; ++t) { ATT_STAGE_LD(t); ATT_STAGE_ST(t); ATT_BAR(); }
        }
        if (NT - 1 <= wlast) { ATT_PVL(vsl + ((NT - 1) & 1) * 128 * AV_STRIDE) ATT_PVM(); }
#undef ATT_STAGE_LD
#undef ATT_STAGE_ST
        ATT_BAR();
#undef ATT_QK
#undef ATT_MASK
#undef ATT_SM
#undef ATT_SM1
#undef ATT_PVL
#undef ATT_PVM
#undef ATT_LDG
        const int xidx = (lane ^ 32) << 2;
        const float ltot = lrun + __uint_as_float((unsigned)__builtin_amdgcn_ds_bpermute(xidx, (int)__float_as_uint(lrun)));
        const float inv = 1.0f / ltot;
        if (r == 0) {
#pragma unroll
            for (int b = 0; b < 4; ++b)
#pragma unroll
                for (int i = 0; i < 8; ++i) o0s[(b * 8 + i) * 64] = pk2(o[b][2 * i] * inv, o[b][2 * i + 1] * inv);
        } else {
            float ss = 0.f;
#pragma unroll
            for (int b = 0; b < 4; ++b)
#pragma unroll
                for (int i = 0; i < 8; ++i) { const unsigned w = o0s[(b * 8 + i) * 64];
                    const float v0 = bflo(w) - lam * (o[b][2 * i] * inv), v1 = bfhi(w) - lam * (o[b][2 * i + 1] * inv);
                    o[b][2 * i] = v0; o[b][2 * i + 1] = v1; ss += v0 * v0 + v1 * v1; }
            ss += __uint_as_float((unsigned)__builtin_amdgcn_ds_bpermute(xidx, (int)__float_as_uint(ss)));
            const float rs = rsqrtf(ss * (1.0f / 128.0f) + EPS) * outscale;
            const bf16* Sub = SAZ + tok0 * 1024 + h * 128; bf16* Oub = Oo + tok0 * 1024 + h * 128;
            const int rowoff = (q0 + r32) * 1024;
#pragma unroll
            for (int b = 0; b < 4; ++b)
#pragma unroll
                for (int g4 = 0; g4 < 4; ++g4) {
                    const int e = 32 * b + 8 * g4 + 4 * hi;
                    const f32x4 gv = *(const f32x4*)(ang + e);
                    const u32x2 zw = *(const u32x2*)(Sub + rowoff + e);
                    u32x2 w;
                    w.x = pk2(o[b][4 * g4 + 0] * rs * gv.x * bflo(zw.x), o[b][4 * g4 + 1] * rs * gv.y * bfhi(zw.x));
                    w.y = pk2(o[b][4 * g4 + 2] * rs * gv.z * bflo(zw.y), o[b][4 * g4 + 3] * rs * gv.w * bfhi(zw.y));
                    *(u32x2*)(Oub + rowoff + e) = w;
                    if (g4 & 1) asm volatile("" ::: "memory");
                }
        }
    }
}

constexpr int ML_STRIDE = 72;
__device__ __forceinline__ void conv8(const bf16* BQK, const float* cw, const float* cb, size_t tok0, int c, int t, int ch0, float (&outv)[8]) {
    const f32x4 b0 = *(const f32x4*)(cb + ch0), b1 = *(const f32x4*)(cb + ch0 + 4);
    float a[8] = {b0.x, b0.y, b0.z, b0.w, b1.x, b1.y, b1.z, b1.w};
#pragma unroll
    for (int j = 0; j < 4; ++j) {
        const int tt = t - 3 + j;
        if (c > 0 || tt >= 0) {
            const u32x4 xv = *(const u32x4*)(BQK + (size_t)((long)tok0 + tt) * 1024 + ch0);
            const f32x4 w0 = *(const f32x4*)(cw + j * 1024 + ch0), w1 = *(const f32x4*)(cw + j * 1024 + ch0 + 4);
            a[0] += w0.x * bflo(xv.x); a[1] += w0.y * bfhi(xv.x); a[2] += w0.z * bflo(xv.y); a[3] += w0.w * bfhi(xv.y);
            a[4] += w1.x * bflo(xv.z); a[5] += w1.y * bfhi(xv.z); a[6] += w1.z * bflo(xv.w); a[7] += w1.w * bfhi(xv.w);
        }
    }
#pragma unroll
    for (int i = 0; i < 8; ++i) outv[i] = a[i] * sigm(a[i]);
}
__device__ __forceinline__ float log_sigmoid(float x) { return fminf(x, 0.f) - log1pf(__expf(-fabsf(x))); }
__device__ __forceinline__ float prefix_sum64(float v, int lane) {
#pragma unroll
    for (int o = 1; o < 64; o <<= 1) { const float n = __shfl_up(v, o); if (lane >= o) v += n; }
    return v;
}
__device__ __forceinline__ float prefix_max64(float v, int lane) {
#pragma unroll
    for (int o = 1; o < 64; o <<= 1) { const float n = __shfl_up(v, o); if (lane >= o) v = fmaxf(v, n); }
    return v;
}
__device__ __forceinline__ f32x4 mma16(const LAS bf16* A, const LAS bf16* Bt, int m0, int n0, int fr, int fq) {
    f32x4 acc = {0.f, 0.f, 0.f, 0.f};
#pragma unroll
    for (int k0 = 0; k0 < 64; k0 += 32) {
        const bf16x8 a = *(const LAS bf16x8*)(A + (m0 + fr) * ML_STRIDE + k0 + 8 * fq);
        const bf16x8 b = *(const LAS bf16x8*)(Bt + (n0 + fr) * ML_STRIDE + k0 + 8 * fq);
        acc = __builtin_amdgcn_mfma_f32_16x16x32_bf16(a, b, acc, 0, 0, 0);
    }
    return acc;
}
__device__ __forceinline__ void stage_vt(LAS bf16* Vt, const bf16* VT, int vrow0, size_t tok0, int tid) {
#pragma unroll
    for (int i = 0; i < 2; ++i) { const int idx = tid + 512 * i, e = idx >> 3, ch = idx & 7;
        *(LAS u32x4*)(Vt + e * ML_STRIDE + ch * 8) = *(const u32x4*)(VT + (size_t)(vrow0 + e) * TH + tok0 + ch * 8); }
    if (tid < 128) { const int e = 128 + (tid >> 3), ch = tid & 7; const unsigned v = (e == 128) ? 0x3f803f80u : 0u; *(LAS u32x4*)(Vt + e * ML_STRIDE + ch * 8) = (u32x4){v, v, v, v}; }
}
__device__ __forceinline__ void mlstm_m1(LAS unsigned char* lds, const bf16* BQK, const bf16* VT, const float* GATES, const float* cw, const float* cb, const float* igb, const float* fgb,
                                         float* CST, float* MST, int ci) {
    int tid_l = threadIdx.x; asm volatile("" : "+v"(tid_l));
    const int tid = tid_l, lane = tid & 63, wave = __builtin_amdgcn_readfirstlane(tid >> 6), fr = lane & 15, fq = lane >> 4;
    const int c = ci & 127, h = (ci >> 7) & 7, bl = ci >> 10; const size_t tok0 = (size_t)bl * SEQ + c * 64;
    LAS bf16* KtW = (LAS bf16*)lds; LAS bf16* Vt = (LAS bf16*)(lds + 64 * ML_STRIDE * 2); LAS float* wsh = (LAS float*)(lds + (64 + 144) * ML_STRIDE * 2);
    if (wave == 0) {
        const float fp = GATES[(tok0 + lane) * 16 + 8 + h] + fgb[h], ip = GATES[(tok0 + lane) * 16 + h] + igb[h];
        const float b = prefix_sum64(log_sigmoid(fp), lane);
        const float blast = __shfl(b, 63);
        const float wl = blast - b + ip; const float ml = wave_max(wl);
        wsh[lane] = __expf(wl - ml);
        if (lane == 0) { MST[ci * 4 + 0] = ml; MST[ci * 4 + 1] = blast; }
    }
    stage_vt(Vt, VT, 1024 + h * 128, tok0, tid);
    float kv[8]; const int t = tid >> 3, d8 = (tid & 7) * 8;
    conv8(BQK, cw, cb, tok0, c, t, 512 + h * 64 + d8, kv);
    __syncthreads();
    { const float w = wsh[t];
#pragma unroll
      for (int i = 0; i < 8; ++i) KtW[(d8 + i) * ML_STRIDE + t] = (bf16)f2bf(kv[i] * w); }
    __syncthreads();
    const int nb = wave & 3, half = wave >> 2; bf16* cst = (bf16*)CST + (size_t)ci * CST_STRIDE;
#pragma unroll
    for (int j = 0; j < 4; ++j) { const int mb = half * 4 + j; const f32x4 a = mma16(Vt, KtW, 16 * mb, 16 * nb, fr, fq);
#pragma unroll
        for (int i = 0; i < 4; ++i) cst[(16 * mb + 4 * fq + i) * 64 + 16 * nb + fr] = (bf16)f2bf(a[i]); }
    if (half == 0) { const f32x4 a = mma16(Vt, KtW, 128, 16 * nb, fr, fq); if (fq == 0) cst[128 * 64 + 16 * nb + fr] = (bf16)f2bf(a[0]); }
    __syncthreads();
}
__device__ __forceinline__ void mlstm_m2(float* CST, float* MST) {
    int t_l = threadIdx.x; asm volatile("" : "+v"(t_l));
    constexpr int NPAIR = CST_STRIDE / 2;
#pragma unroll 1
    for (int g = blockIdx.x * 512 + t_l; g < 16 * NPAIR; g += gridDim.x * 512) {
        const int seq = g / NPAIR, pr = g % NPAIR;
        float m = -1e30f, st0 = 0.f, st1 = 0.f;
        unsigned* p = (unsigned*)CST + (size_t)seq * 128 * NPAIR + pr; float* ms = MST + (size_t)seq * 128 * 4;
#pragma unroll 1
        for (int c0 = 0; c0 < 128; c0 += 16) {
            unsigned cw[16]; float ml[16], bl[16];
#pragma unroll
            for (int j = 0; j < 16; ++j) { cw[j] = p[(size_t)(c0 + j) * NPAIR]; ml[j] = ms[(c0 + j) * 4 + 0]; bl[j] = ms[(c0 + j) * 4 + 1]; }
#pragma unroll
            for (int j = 0; j < 16; ++j) {
                const float mnew = fmaxf(bl[j] + m, ml[j]); const float a = __expf(bl[j] + m - mnew), e = __expf(ml[j] - mnew);
                p[(size_t)(c0 + j) * NPAIR] = pk2(st0, st1); if (pr == 0) ms[(c0 + j) * 4 + 2] = m;
                st0 = a * st0 + e * bflo(cw[j]); st1 = a * st1 + e * bfhi(cw[j]); m = mnew;
            }
        }
    }
}
__device__ __forceinline__ void mlstm_m3(LAS unsigned char* lds, const bf16* BQK, const bf16* VT, const float* GATES, const float* cw, const float* cb, const float* igb, const float* fgb,
                                         const float* CST, const float* MST, const float* mng, const bf16* BOG, bf16* HB, int ci) {
    int tid_l = threadIdx.x; asm volatile("" : "+v"(tid_l));
    const int tid = tid_l, lane = tid & 63, wave = __builtin_amdgcn_readfirstlane(tid >> 6), fr = lane & 15, fq = lane >> 4;
    const int c = ci & 127, h = (ci >> 7) & 7, bl = ci >> 10; const size_t tok0 = (size_t)bl * SEQ + c * 64;
    constexpr int RB = ML_STRIDE * 2;
    LAS bf16* Qs = (LAS bf16*)lds; LAS bf16* Ks = (LAS bf16*)(lds + 64 * RB); LAS bf16* Vt = (LAS bf16*)(lds + 128 * RB); LAS bf16* Ct = (LAS bf16*)(lds + 272 * RB);
    LAS bf16* Ps = (LAS bf16*)(lds + 416 * RB); LAS float* Hs = (LAS float*)(lds + 480 * RB); LAS float* gsh = (LAS float*)(lds + 480 * RB + 64 * 132 * 4);
    if (wave == 0) {
        const float fp = GATES[(tok0 + lane) * 16 + 8 + h] + fgb[h], ip = GATES[(tok0 + lane) * 16 + h] + igb[h];
        const float b = prefix_sum64(log_sigmoid(fp), lane);
        const float g = ip - b; const float pm = prefix_max64(g, lane);
        const float mprev = MST[ci * 4 + 2];
        const float M = fmaxf(mprev, pm);
        gsh[lane] = g; gsh[64 + lane] = M; gsh[128 + lane] = __expf(mprev - M); gsh[192 + lane] = __expf(-(b + M));
    }
    stage_vt(Vt, VT, 1024 + h * 128, tok0, tid);
    { const bf16* cst = (const bf16*)CST + (size_t)ci * CST_STRIDE;
      for (int i = tid; i < 129 * 8; i += 512) { const int e = i >> 3, ch = i & 7; *(LAS u32x4*)(Ct + e * ML_STRIDE + ch * 8) = *(const u32x4*)(cst + e * 64 + ch * 8); }
      if (tid < 120) { const int e = 129 + (tid >> 3), ch = tid & 7; unsigned z = 0u; asm volatile("" : "+v"(z)); *(LAS u32x4*)(Ct + e * ML_STRIDE + ch * 8) = (u32x4){z, z, z, z}; } }
    { float v[8]; const int t = tid >> 3, d8 = (tid & 7) * 8;
      conv8(BQK, cw, cb, tok0, c, t, h * 64 + d8, v);
      *(LAS u32x4*)(Qs + t * ML_STRIDE + d8) = (u32x4){pk2(v[0] * 0.125f, v[1] * 0.125f), pk2(v[2] * 0.125f, v[3] * 0.125f), pk2(v[4] * 0.125f, v[5] * 0.125f), pk2(v[6] * 0.125f, v[7] * 0.125f)};
      conv8(BQK, cw, cb, tok0, c, t, 512 + h * 64 + d8, v);
      *(LAS u32x4*)(Ks + t * ML_STRIDE + d8) = (u32x4){pk2(v[0], v[1]), pk2(v[2], v[3]), pk2(v[4], v[5]), pk2(v[6], v[7])}; }
    __syncthreads();
    { const int mb = wave & 3;
#pragma unroll
      for (int j = 0; j < 2; ++j) { const int nb = (wave >> 2) * 2 + j;
          f32x4 a = {0.f, 0.f, 0.f, 0.f};
          if (nb <= mb) a = mma16(Qs, Ks, 16 * mb, 16 * nb, fr, fq);
          const int s = 16 * nb + fr; const float gs = gsh[s];
#pragma unroll
          for (int i = 0; i < 4; ++i) { const int t = 16 * mb + 4 * fq + i; const float sc = (s <= t) ? a[i] * __expf(gs - gsh[64 + t]) : 0.f; Ps[t * ML_STRIDE + s] = (bf16)f2bf(sc); } } }
    __syncthreads();
    { const int mb = wave & 3, half = wave >> 2;
      f32x4 dn = mma16(Ps, Vt, 16 * mb, 128, fr, fq); const f32x4 dn2 = mma16(Qs, Ct, 16 * mb, 128, fr, fq);
      float den[4], iwv[4], emv[4];
#pragma unroll
      for (int i = 0; i < 4; ++i) { const int t = 16 * mb + 4 * fq + i; iwv[i] = gsh[128 + t]; emv[i] = gsh[192 + t]; const float d = dn[i] + iwv[i] * dn2[i]; den[i] = __shfl(d, lane & 48); }
#pragma unroll
      for (int j = 0; j < 4; ++j) { const int eb = half * 4 + j;
          const f32x4 a1 = mma16(Ps, Vt, 16 * mb, 16 * eb, fr, fq), a2 = mma16(Qs, Ct, 16 * mb, 16 * eb, fr, fq);
#pragma unroll
          for (int i = 0; i < 4; ++i) { const int t = 16 * mb + 4 * fq + i; Hs[t * 132 + 16 * eb + fr] = (a1[i] + iwv[i] * a2[i]) / fmaxf(fabsf(den[i]), emv[i]); } } }
    __syncthreads();
#pragma unroll
    for (int j = 0; j < 8; ++j) { const int t = wave * 8 + j; const float v0 = Hs[t * 132 + 2 * lane], v1 = Hs[t * 132 + 2 * lane + 1];
        const float rs = rsqrtf(wave_sum(v0 * v0 + v1 * v1) * (1.0f / 128.0f) + EPS);
        const size_t off = (tok0 + t) * 1024 + h * 128 + 2 * lane; const unsigned gw = *(const unsigned*)(BOG + off);
        *(unsigned*)(HB + off) = pk2(v0 * rs * mng[2 * lane] * bflo(gw), v1 * rs * mng[2 * lane + 1] * bfhi(gw)); }
    __syncthreads();
}

#define XB_TMO      128
#define XB_XCNT(j)  (256  + 64 * (j))
#define XB_XSUB(j)  (1280 + 64 * (j))
#define XB_XGEN(j)  (2304 + 64 * (j))
#define XB_TOP      3328
#define XB_TOPGEN   3392
#define XCD_BAR_WORDS 3456
#define XB_SPIN_CAP (1u << 18)

__device__ __forceinline__ unsigned xb_ld(unsigned* p)              { return __hip_atomic_load(p, __ATOMIC_RELAXED, __HIP_MEMORY_SCOPE_AGENT); }
__device__ __forceinline__ unsigned xb_add(unsigned* p, unsigned v) { return __hip_atomic_fetch_add(p, v, __ATOMIC_RELAXED, __HIP_MEMORY_SCOPE_AGENT); }
__device__ __forceinline__ unsigned xb_xcc_id() { return (unsigned)__builtin_amdgcn_s_getreg((3 << 11) | 20) & 0xFu; }
#define XB_SPIN(cond, bar) do { unsigned _sp = 0; while (cond) { __builtin_amdgcn_s_sleep(1); \
    if ((++_sp & 255u) == 0u) { if (xb_ld(&(bar)[XB_TMO])) break; if (_sp > XB_SPIN_CAP) { atomicAdd(&(bar)[XB_TMO], 1u); break; } } } } while (0)

struct XcdBarrier {
    unsigned* bar; unsigned x;
    volatile LAS unsigned* st;
};

__device__ __forceinline__ XcdBarrier xcd_barrier_post(unsigned* bar, volatile LAS unsigned* st) {
    XcdBarrier b; b.bar = bar; b.x = xb_xcc_id(); b.st = st;
    if (threadIdx.x == 0) (void)xb_add(&bar[XB_XCNT(b.x)], 1u);
    return b;
}
__device__ __forceinline__ void xcd_barrier_complete(unsigned* bar, unsigned x, unsigned& nloc, unsigned& nx) {
    const unsigned G = gridDim.x * gridDim.y * gridDim.z;
    unsigned sum, cnt, mine, sp = 0u;
    for (;;) {
        sum = 0u; cnt = 0u; mine = 0u;
#pragma unroll
        for (unsigned j = 0; j < 16; ++j) { const unsigned c = xb_ld(&bar[XB_XCNT(j)]); sum += c; cnt += (c > 0u) ? 1u : 0u; mine = (j == x) ? c : mine; }
        if (sum == G) break;
        __builtin_amdgcn_s_sleep(1);
        if ((++sp & 255u) == 0u) { if (xb_ld(&bar[XB_TMO])) break; if (sp > XB_SPIN_CAP) { atomicAdd(&bar[XB_TMO], 1u); break; } }
    }
    nloc = mine > 0u ? mine : 1u; nx = cnt > 0u ? cnt : 1u;
}

__device__ __forceinline__ void xcd_barrier(const XcdBarrier& b) {
    asm volatile("s_waitcnt vmcnt(0)" ::: "memory");
    __syncthreads();
    if (threadIdx.x == 0) {
        unsigned* bar = b.bar;
        __builtin_amdgcn_s_waitcnt(0);
        unsigned nloc = b.st[0], nx = b.st[1];
        if (nloc == 0u) { xcd_barrier_complete(bar, b.x, nloc, nx); b.st[0] = nloc; b.st[1] = nx; }
        const unsigned old = xb_add(&bar[XB_XSUB(b.x)], 1u);
        const unsigned gen = old / nloc;
        if (old + 1u == (gen + 1u) * nloc) {
            __builtin_amdgcn_fence(__ATOMIC_RELEASE, "agent");
            asm volatile("s_waitcnt vmcnt(0)" ::: "memory");
            const unsigned og = xb_add(&bar[XB_TOP], 1u);
            const unsigned tg = og / nx;
            if (og + 1u == (tg + 1u) * nx) xb_add(&bar[XB_TOPGEN], 1u);
            else XB_SPIN(xb_ld(&bar[XB_TOPGEN]) == tg, bar);
            __builtin_amdgcn_fence(__ATOMIC_ACQUIRE, "agent");
            xb_add(&bar[XB_XGEN(b.x)], 1u);
            asm volatile("s_waitcnt vmcnt(0)" ::: "memory");
        } else {
            XB_SPIN(xb_ld(&bar[XB_XGEN(b.x)]) == gen, bar);
            __builtin_amdgcn_fence(__ATOMIC_ACQUIRE, "agent");
            asm volatile("s_waitcnt vmcnt(0)" ::: "memory");
        }
    }
    __syncthreads();
}
#define KPL() ({ KParams k_ = KP0; asm volatile("" : "+s"(k_)); k_; })
#define WSP(T, off) ((T*)(ws + (off)))
__device__ __forceinline__ int tid_fresh() { int t = threadIdx.x; asm volatile("" : "+v"(t)); return t; }
#ifndef NREP_B
#define NREP_B 1
#endif
#ifndef NREP_F
#define NREP_F 1
#endif
#ifndef NREP_P
#define NREP_P 1
#endif
#ifndef NREP_M
#define NREP_M 1
#endif
#ifndef NREP_ATT
#define NREP_ATT 1
#endif
#define GRID_SYNC() do { XcdBarrier xb_; xb_.bar = (unsigned*)(KPL()->ws + WS_CTL) + 4096; xb_.x = xb_xcc_id(); xb_.st = (volatile LAS unsigned*)(lds + LDS_BYTES - 64); xcd_barrier(xb_); } while (0)
__global__ void __launch_bounds__(512, 2) hybrid_fwd(Params P_unused) {
    extern __shared__ __attribute__((aligned(16))) unsigned char lds_raw[];
    LAS unsigned char* lds = (LAS unsigned char*)lds_raw;
    const KParams KP0 = (KParams)__builtin_amdgcn_kernarg_segment_ptr();
    const int G = gridDim.x, bx = blockIdx.x;
    volatile LAS unsigned* xb_st = (volatile LAS unsigned*)(lds + LDS_BYTES - 64);
    if (threadIdx.x < 2) xb_st[threadIdx.x] = 0u;
    __syncthreads();
    (void)xcd_barrier_post((unsigned*)(KP0->ws + WS_CTL) + 4096, xb_st);
    cg::this_grid().sync();
#pragma unroll 1
    for (int rep = 0; rep < NREP_P; ++rep)
    { const int tid = tid_fresh(); prologue(KPL(), lds, __builtin_amdgcn_readfirstlane(tid >> 6), tid & 63); }
#pragma unroll 1
    for (int l_o = 0; l_o < NLAYER; ++l_o) {
#pragma unroll 1
        for (int hf_o = 0; hf_o < 2; ++hf_o) {
            { KParams kp = KPL(); unsigned char* ws = kp->ws; int l = l_o, hf = hf_o; asm volatile("" : "+s"(l), "+s"(hf)); (void)l; (void)hf; const int tid = tid_fresh();
              const float* xin = (l == 0 ? kp->in[0] : kp->out) + (size_t)hf * TH * DM;
              rmsnorm_phase(xin, kp->in[2] + l * DM, WSP(bf16, WS_H), __builtin_amdgcn_readfirstlane(tid >> 6), tid & 63); }
            GRID_SYNC();
#pragma unroll 1
            for (int rep = 0; rep < NREP_B; ++rep)
            { KParams kp = KPL(); unsigned char* ws = kp->ws; int l = l_o, hf = hf_o; asm volatile("" : "+s"(l), "+s"(hf)); (void)l; (void)hf;
              gates_phase(WSP(const bf16, WS_H), WSP(const bf16, WS_WTIN) + ((size_t)l * WT_ROWS + 8192) * 1024, WSP(float, WS_GATES)); }
            { KParams kp = KPL(); unsigned char* ws = kp->ws; int l = l_o, hf = hf_o; asm volatile("" : "+s"(l), "+s"(hf)); (void)l; (void)hf; const bf16* WTin = WSP(const bf16, WS_WTIN) + (size_t)l * WT_ROWS * 1024;
              { pg8::Gemm g{WSP(bf16, WS_H), WTin, TH, 8192, 1024}; pg8::StaticOrder S; S.init(TH, 8192, G, bx);
                pg8::EpiMain E{ws,
                               kp->in[4] + l * 64, kp->in[5] + l * 64, WSP(const float, WS_COS) + (size_t)hf * TH * 32, WSP(const float, WS_SIN) + (size_t)hf * TH * 32, QSCALE};
                pg8::gemm_phase<pg8::EpiMain, pg8::StaticOrder, true, true>(lds, g, S, E); }
              { pg8::Gemm g{WTin + (size_t)8448 * 1024, WSP(bf16, WS_H), 2048, TH, 1024}; pg8::StaticOrder S; S.init(2048, TH, G, bx);
                pg8::EpiPlain E{WSP(bf16, WS_VT), TH};
                pg8::gemm_phase<pg8::EpiPlain, pg8::StaticOrder, true, true>(lds, g, S, E); } }
            GRID_SYNC();
#pragma unroll 1
            for (int rep = 0; rep < NREP_M; ++rep)
            { KParams kp = KPL(); unsigned char* ws = kp->ws; int l = l_o, hf = hf_o; asm volatile("" : "+s"(l), "+s"(hf)); (void)l; (void)hf;
              for (int ci = bx; ci < NCHUNK_H; ci += G)
                  mlstm_m1(lds, WSP(bf16, WS_BQK), WSP(bf16, WS_VT), WSP(float, WS_GATES), kp->in[9] + l * 4096, kp->in[10] + l * 1024, kp->in[11] + l * 8, kp->in[12] + l * 8, WSP(float, WS_CST), WSP(float, WS_MST), ci); }
            GRID_SYNC();
            { KParams kp = KPL(); unsigned char* ws = kp->ws; int l = l_o, hf = hf_o; asm volatile("" : "+s"(l), "+s"(hf)); (void)l; (void)hf; mlstm_m2(WSP(float, WS_CST), WSP(float, WS_MST)); }
            GRID_SYNC();
#pragma unroll 1
            for (int ord = 0; ord < 2; ++ord) {
              const bool run_m3 = ((ord == 0) != (((bx >> 3) & 1) != 0));
              if (run_m3) {
#pragma unroll 1
            for (int rep = 0; rep < NREP_M; ++rep)
            { KParams kp = KPL(); unsigned char* ws = kp->ws; int l = l_o, hf = hf_o; asm volatile("" : "+s"(l), "+s"(hf)); (void)l; (void)hf;
              for (int ci = bx; ci < NCHUNK_H; ci += G)
                  mlstm_m3(lds, WSP(bf16, WS_BQK), WSP(bf16, WS_VT), WSP(float, WS_GATES), kp->in[9] + l * 4096, kp->in[10] + l * 1024, kp->in[11] + l * 8, kp->in[12] + l * 8,
                           WSP(float, WS_CST), WSP(float, WS_MST), kp->in[13] + l * 128, WSP(bf16, WS_BOG), WSP(bf16, WS_H), ci); }
              } else {
            { KParams kp = KPL(); unsigned char* ws = kp->ws; int l = l_o, hf = hf_o; asm volatile("" : "+s"(l), "+s"(hf)); (void)l; (void)hf; const int lane = tid_fresh() & 63;
              const float* lq = kp->in[6] + l * 256; const float s1 = wave_sum(lq[lane] * lq[64 + lane]), s2 = wave_sum(lq[128 + lane] * lq[192 + lane]);
              const float lam_init = kp->lam_init[l]; const float lam = __expf(s1) - __expf(s2) + lam_init;
              const float gqm = wave_max(fabsf(kp->in[4][l * 64 + lane])), gkm = wave_max(fabsf(kp->in[5][l * 64 + lane]));
              const float negshift = -fmaxf(0.f, QSCALE * 64.0f * gqm * gkm - 24.0f);
#pragma unroll 1
              for (int rep = ((l_o == 0 && hf_o == 0) ? NREP_ATT : 1) - 1; rep >= 0; --rep)
              for (int pr = bx; pr < 256; pr += G) {
                  const int pv = (G == 256) ? ((pr & 7) * 32 + (pr >> 3)) : pr;
                  const int bl = pv >> 7, h = (pv >> 4) & 7, s = pv & 15;
                  attn_unit(lds, WSP(bf16, WS_Q), rep ? (bf16*)kp->out : WSP(bf16, WS_Q), WSP(bf16, WS_K), WSP(bf16, WS_VT), WSP(bf16, WS_SAZ), kp->in[7] + l * 128, lam, 1.0f - lam_init, negshift, bl, h, 31 - s);
                  attn_unit(lds, WSP(bf16, WS_Q), rep ? (bf16*)kp->out : WSP(bf16, WS_Q), WSP(bf16, WS_K), WSP(bf16, WS_VT), WSP(bf16, WS_SAZ), kp->in[7] + l * 128, lam, 1.0f - lam_init, negshift, bl, h, s);
              } }
              }
            }
            GRID_SYNC();
#pragma unroll 1
            for (int rep = 0; rep < NREP_F; ++rep)
            { KParams kp = KPL(); unsigned char* ws = kp->ws; int l = l_o, hf = hf_o; asm volatile("" : "+s"(l), "+s"(hf)); (void)l; (void)hf;
              { pg8::Gemm g{WSP(bf16, WS_Q), WSP(const bf16, WS_WTOA) + (size_t)l * 1024 * 1024, TH, 1024, 1024}; pg8::StaticOrder S; S.init(TH, 1024, G, bx);
                pg8::EpiOutA E{WSP(bf16, WS_K), WSP(bf16, WS_SGA)};
                pg8::gemm_phase<pg8::EpiOutA, pg8::StaticOrder, true, true>(lds, g, S, E); }
              { pg8::Gemm g{WSP(bf16, WS_H), WSP(const bf16, WS_WTOB) + (size_t)l * 1024 * 1024, TH, 1024, 1024}; pg8::StaticOrder S; S.init(TH, 1024, G, bx);
                pg8::EpiOutB E{WSP(bf16, WS_K), WSP(bf16, WS_SGB)};
                pg8::gemm_phase<pg8::EpiOutB, pg8::StaticOrder, true, true>(lds, g, S, E); } }
            GRID_SYNC();
            { KParams kp = KPL(); unsigned char* ws = kp->ws; int l = l_o, hf = hf_o; asm volatile("" : "+s"(l), "+s"(hf)); (void)l; (void)hf;
              const float* xin = (l == 0 ? kp->in[0] : kp->out) + (size_t)hf * TH * DM; float* xout = kp->out + (size_t)hf * TH * DM;
              pg8::Gemm g{WSP(bf16, WS_K), WSP(const bf16, WS_WTO) + (size_t)l * 1024 * 1024, TH, 1024, 1024}; pg8::StaticOrder S; S.init(TH, 1024, G, bx);
              pg8::EpiFinal E{xin, xout};
              pg8::gemm_phase<pg8::EpiFinal, pg8::StaticOrder, true, true>(lds, g, S, E); }
            __syncthreads();
        }
    }
}

extern "C" void kernel_launch(void* const* d_in, const int* in_sizes, int n_in, void* d_out, int out_size, void* d_ws, size_t ws_size, hipStream_t stream) {
    static int grid_blocks = 0;
    if (grid_blocks == 0) {
        if (n_in != 16 || out_size != NTOK * DM || ws_size < WS_END) { fprintf(stderr, "kernel_launch: unexpected shapes / workspace (%d inputs, out %d, ws %zu)\n", n_in, out_size, ws_size); grid_blocks = -1; return; }
        int dev = 0, cus = 0, per_cu = 0;
        hipGetDevice(&dev); hipDeviceGetAttribute(&cus, hipDeviceAttributeMultiprocessorCount, dev);
        hipFuncSetAttribute((const void*)hybrid_fwd, hipFuncAttributeMaxDynamicSharedMemorySize, LDS_BYTES);
        hipOccupancyMaxActiveBlocksPerMultiprocessor(&per_cu, (const void*)hybrid_fwd, 512, LDS_BYTES);
        (void)hipGetLastError();
        if (per_cu < 1) per_cu = 1;
        grid_blocks = cus;
    }
    if (grid_blocks < 0) return;
    Params p{};
    for (int i = 0; i < 16; ++i) p.in[i] = (const float*)d_in[i];
    p.out = (float*)d_out; p.ws = (unsigned char*)d_ws;
    for (int i = 0; i < 32; ++i) p.inv_freq[i] = (float)pow(10000.0, -(double)(2 * i) / 64.0);
    for (int l = 0; l < 2; ++l) p.lam_init[l] = (float)(0.8 - 0.6 * exp(-0.3 * (double)l));
    if (hipMemsetAsync((char*)d_ws + WS_CTL, 0, 65536, stream) != hipSuccess) { fprintf(stderr, "kernel_launch: memset of the barrier words failed\n"); return; }
    void* args[] = {&p};
    hipError_t e = hipLaunchCooperativeKernel((void*)hybrid_fwd, dim3(grid_blocks), dim3(512), args, LDS_BYTES, stream);
    if (e != hipSuccess) fprintf(stderr, "cooperative launch failed: %s (grid %d)\n", hipGetErrorString(e), grid_blocks);
}
```

```cpp
#include <hip/hip_runtime.h>
#include <cstdio>
#include <cstdint>
#include <cmath>
constexpr int NB = 4, SEQ = 8192, DM = 1024, NTOK = NB * SEQ, TH = NTOK / 2, NLAYER = 2, DIN = 10256;
constexpr int WT_ROWS = 10496;
constexpr int NCHUNK_H = 2 * 8 * 128;
constexpr int CST_STRIDE = 129 * 64;
constexpr float EPS = 1e-6f;
constexpr float QSCALE = 0.125f * 1.4426950408889634f;
constexpr size_t MiB = 1u << 20;
constexpr size_t WS_CTL = 0, WS_WTIN = 1 * MiB, WS_WTOA = 43 * MiB, WS_WTOB = 47 * MiB, WS_WTO = 51 * MiB, WS_COS = 55 * MiB, WS_SIN = 59 * MiB,
                 WS_H = 64 * MiB, WS_Q = 96 * MiB, WS_K = 128 * MiB, WS_SAZ = 160 * MiB, WS_BQK = 192 * MiB, WS_VT = 224 * MiB, WS_BOG = 288 * MiB,
                 WS_SGA = 320 * MiB, WS_SGB = 352 * MiB, WS_GATES = 384 * MiB, WS_MST = 385 * MiB, WS_CST = 386 * MiB, WS_END = 452 * MiB;
static_assert((size_t)WT_ROWS * 1024 * 2 * 2 <= WS_WTOA - WS_WTIN, "wt_in copies");
static_assert((size_t)NCHUNK_H * CST_STRIDE * 4 <= WS_END - WS_CST, "states");
namespace pg8 {
#define PG8_LAS __attribute__((address_space(3)))
typedef unsigned short bf16_t;
typedef short bf16x8 __attribute__((ext_vector_type(8)));
typedef float f32x4 __attribute__((ext_vector_type(4)));
typedef unsigned u32x4 __attribute__((ext_vector_type(4)));
constexpr int BM = 256, BK = 64, HALF = 128, HTB = HALF * BK * 2  , STAGE_BYTES = 8 * HTB, NXCD = 8, WGM = 8;

__host__ __device__ __forceinline__ int lds_byte(int r, int c) { const int st = (r >> 4) * 2 + (c >> 5), rr = r & 15, cc = c & 31, ob = rr * 64 + cc * 2; return st * 1024 + (ob ^ (((ob >> 9) & 1) << 5)); }
__host__ __device__ __forceinline__ void stage_rc(int b, int& R, int& C) { const int st = b / 1024, sb = b % 1024, swz = sb ^ (((sb >> 9) & 1) << 5); R = (st >> 1) * 16 + swz / 64; C = (st & 1) * 32 + (swz % 64) / 2; }
__host__ __device__ __forceinline__ int perm32(int rho) { const int n = rho >> 4, i = rho & 15; return 8 * (i >> 2) + 4 * n + (i & 3); }

struct Unit { int pm, pn; };
struct Gemm { const bf16_t* A; const bf16_t* Bt; int M, N, K; };

struct StaticOrder {
    int nM, nN, nwg, G, c;
    __host__ __device__ void init(int M, int N, int G_, int c_) { nM = M / BM; nN = N / BM; nwg = nM * nN; G = G_; c = c_; }
    __host__ __device__ bool next(int i, Unit& u) const {
        const long L = (long)i * G + c; if (L >= nwg) return false;
        int wgid = (int)L; { const int q = nwg / NXCD, r = nwg % NXCD, xcd = wgid % NXCD, off = wgid / NXCD; wgid = (xcd < r ? xcd * (q + 1) : r * (q + 1) + (xcd - r) * q) + off; }
        const int nig = WGM * nN, gid = wgid / nig, fm = gid * WGM, gsz = (nM - fm) < WGM ? (nM - fm) : WGM;
        u.pm = fm + ((wgid % nig) % gsz); u.pn = (wgid % nig) / gsz; return true;
    }
    __device__ __forceinline__ void a_ready(const Unit&) const {}
    __device__ __forceinline__ void done(const Unit&) const {}
};

typedef float f32x2c_t __attribute__((ext_vector_type(2))); typedef __bf16 bf16x2c_t __attribute__((ext_vector_type(2)));
__device__ __forceinline__ unsigned cvt_pk_bf16(float lo, float hi) { f32x2c_t v = {lo, hi}; bf16x2c_t b = __builtin_convertvector(v, bf16x2c_t); return __builtin_bit_cast(unsigned, b); }
typedef float f32x2 __attribute__((ext_vector_type(2)));
typedef unsigned u32x4e __attribute__((ext_vector_type(4)));
__device__ __forceinline__ float sigm(float x) { return __builtin_amdgcn_rcpf(1.0f + __expf(-x)); }
__device__ __forceinline__ u32x4e pack8(const f32x4& a, const f32x4& b) { u32x4e w; w.x = cvt_pk_bf16(a[0], a[1]); w.y = cvt_pk_bf16(a[2], a[3]); w.z = cvt_pk_bf16(b[0], b[1]); w.w = cvt_pk_bf16(b[2], b[3]); return w; }
__device__ __forceinline__ float bf_lo(unsigned w) { return __uint_as_float(w << 16); }
__device__ __forceinline__ float bf_hi(unsigned w) { return __uint_as_float(w & 0xffff0000u); }
__device__ __forceinline__ void unpack8(const u32x4e w, f32x4& a, f32x4& b) { a[0] = bf_lo(w.x); a[1] = bf_hi(w.x); a[2] = bf_lo(w.y); a[3] = bf_hi(w.y); b[0] = bf_lo(w.z); b[1] = bf_hi(w.z); b[2] = bf_lo(w.w); b[3] = bf_hi(w.w); }

struct EpiPlain {
    static constexpr bool PERM = true, AFTER_DRAIN = false;
    bf16_t* O; int ldc;
    __device__ __forceinline__ void operator()(const f32x4 (&acc)[2][2][4][2], const Unit& u, int wr, int wc, int fr, int fq) const {
        const int row0 = u.pm * BM + wr * 64 + fr, col0 = u.pn * BM + wc * 32 + 8 * fq;
#pragma unroll
        for (int ai = 0; ai < 2; ++ai)
#pragma unroll
            for (int m = 0; m < 4; ++m) { bf16_t* rowp = O + (size_t)(row0 + ai * HALF + m * 16) * ldc + col0;
#pragma unroll
                for (int bj = 0; bj < 2; ++bj) *(u32x4e*)(rowp + bj * HALF) = pack8(acc[ai][bj][m][0], acc[ai][bj][m][1]); }
    }
};

struct EpiMain {
    static constexpr bool PERM = true, AFTER_DRAIN = false;
    unsigned char* ws;
    const float *qg, *kg;
    const float *cosT, *sinT;
    float qscale;
    __device__ __forceinline__ void operator()(const f32x4 (&acc)[2][2][4][2], const Unit& u, int wr, int wc, int fr, int fq) const {
        const int pn = u.pn; const int row0 = u.pm * BM + wr * 64 + fr; const int x0 = wc * 32 + 8 * fq;
        if (pn < 8) {
            bf16_t* O = (bf16_t*)(ws + (pn < 4 ? WS_Q : WS_K)); const float* g = pn < 4 ? qg : kg; const float sc = pn < 4 ? qscale : 1.0f;
            const int gcol = (pn & 3) * 256 + wc * 64, j0 = 8 * fq;
#pragma unroll
            for (int ai = 0; ai < 2; ++ai)
#pragma unroll
                for (int m = 0; m < 4; ++m) {
                    const int row = row0 + ai * HALF + m * 16;
                    float ss = 0.f;
#pragma unroll
                    for (int bj = 0; bj < 2; ++bj)
#pragma unroll
                        for (int n = 0; n < 2; ++n) { const f32x4 v = acc[ai][bj][m][n]; ss += (v[0] * v[0] + v[1] * v[1]) + (v[2] * v[2] + v[3] * v[3]); }
                    ss += __shfl_xor(ss, 16); ss += __shfl_xor(ss, 32);
                    const float rs = rsqrtf(ss * (1.0f / 64.0f) + 1e-6f);
                    bf16_t* rowp = O + (size_t)row * 1024 + gcol + j0;
                    u32x4e w1, w2;
#pragma unroll
                    for (int n = 0; n < 2; ++n) {
                        const f32x4 cc = *(const f32x4*)(cosT + (size_t)row * 32 + j0 + 4 * n), sn = *(const f32x4*)(sinT + (size_t)row * 32 + j0 + 4 * n);
                        const f32x4 ga = *(const f32x4*)(g + j0 + 4 * n), gb = *(const f32x4*)(g + 32 + j0 + 4 * n);
                        const f32x4 a = acc[ai][0][m][n] * rs * ga, b = acc[ai][1][m][n] * rs * gb;
                        const f32x4 o1 = (a * cc - b * sn) * sc, o2 = (b * cc + a * sn) * sc;
                        if (n == 0) { w1.x = cvt_pk_bf16(o1[0], o1[1]); w1.y = cvt_pk_bf16(o1[2], o1[3]); w2.x = cvt_pk_bf16(o2[0], o2[1]); w2.y = cvt_pk_bf16(o2[2], o2[3]); }
                        else        { w1.z = cvt_pk_bf16(o1[0], o1[1]); w1.w = cvt_pk_bf16(o1[2], o1[3]); w2.z = cvt_pk_bf16(o2[0], o2[1]); w2.w = cvt_pk_bf16(o2[2], o2[3]); }
                    }
                    *(u32x4e*)(rowp) = w1;
                    *(u32x4e*)(rowp + 32) = w2;
                    if (m == 3) asm volatile("" ::: "memory");
                }
        } else if (pn < 16) {
            bf16_t* O = (bf16_t*)(ws + (pn < 12 ? WS_SAZ : WS_BQK)); const bool act = pn < 12; const int colt = (pn & 3) * 256 + x0;
#pragma unroll
            for (int ai = 0; ai < 2; ++ai)
#pragma unroll
                for (int m = 0; m < 4; ++m) { bf16_t* rowp = O + (size_t)(row0 + ai * HALF + m * 16) * 1024 + colt;
#pragma unroll
                    for (int bj = 0; bj < 2; ++bj) { f32x4 v0 = acc[ai][bj][m][0], v1 = acc[ai][bj][m][1];
                        if (act) {
#pragma unroll
                            for (int e = 0; e < 4; ++e) { v0[e] = v0[e] * sigm(v0[e]); v1[e] = v1[e] * sigm(v1[e]); } }
                        *(u32x4e*)(rowp + bj * HALF) = pack8(v0, v1); } }
        } else if (pn < 24) {
            const int colt = (pn - 16) * 128 + x0;
#pragma unroll
            for (int ai = 0; ai < 2; ++ai)
#pragma unroll
                for (int m = 0; m < 4; ++m) { bf16_t* rowp = (bf16_t*)(ws + WS_BOG) + (size_t)(row0 + ai * HALF + m * 16) * 1024 + colt;
                    f32x4 v0, v1;
#pragma unroll
                    for (int e = 0; e < 4; ++e) { const float o0 = acc[ai][0][m][0][e], z0 = acc[ai][1][m][0][e], o1 = acc[ai][0][m][1][e], z1 = acc[ai][1][m][1][e];
                        v0[e] = sigm(o0) * z0 * sigm(z0); v1[e] = sigm(o1) * z1 * sigm(z1); }
                    *(u32x4e*)(rowp) = pack8(v0, v1); }
        } else if (pn < 32) {
            bf16_t* O = (bf16_t*)(ws + (pn < 28 ? WS_SGA : WS_SGB)); const int colt = (pn & 3) * 256 + x0;
#pragma unroll
            for (int ai = 0; ai < 2; ++ai)
#pragma unroll
                for (int m = 0; m < 4; ++m) { bf16_t* rowp = O + (size_t)(row0 + ai * HALF + m * 16) * 1024 + colt;
#pragma unroll
                    for (int bj = 0; bj < 2; ++bj) { f32x4 v0 = acc[ai][bj][m][0], v1 = acc[ai][bj][m][1];
#pragma unroll
                        for (int e = 0; e < 4; ++e) { v0[e] = sigm(v0[e]); v1[e] = sigm(v1[e]); }
                        *(u32x4e*)(rowp + bj * HALF) = pack8(v0, v1); } }
        } else {
            if (wc == 0 && fq < 2) {
#pragma unroll
                for (int ai = 0; ai < 2; ++ai)
#pragma unroll
                    for (int m = 0; m < 4; ++m) { float* rowp = (float*)(ws + WS_GATES) + (size_t)(row0 + ai * HALF + m * 16) * 16 + 8 * fq;
                        *(f32x4*)(rowp) = acc[ai][0][m][0]; *(f32x4*)(rowp + 4) = acc[ai][0][m][1]; }
            }
        }
    }
};

struct EpiOutA {
    static constexpr bool PERM = true, AFTER_DRAIN = false;
    bf16_t* U; const bf16_t* G;
    __device__ __forceinline__ void operator()(const f32x4 (&acc)[2][2][4][2], const Unit& u, int wr, int wc, int fr, int fq) const {
        const int row0 = u.pm * BM + wr * 64 + fr, col0 = u.pn * BM + wc * 32 + 8 * fq;
#pragma unroll
        for (int ai = 0; ai < 2; ++ai)
#pragma unroll
            for (int m = 0; m < 4; ++m) { const size_t off = (size_t)(row0 + ai * HALF + m * 16) * 1024 + col0;
#pragma unroll
                for (int bj = 0; bj < 2; ++bj) { f32x4 g0, g1; unpack8(*(const u32x4e*)(G + off + bj * HALF), g0, g1);
                    *(u32x4e*)(U + off + bj * HALF) = pack8(acc[ai][bj][m][0] * g0, acc[ai][bj][m][1] * g1); } asm volatile("" ::: "memory"); }
    }
};
struct EpiOutB {
    static constexpr bool PERM = true, AFTER_DRAIN = false;
    bf16_t* U; const bf16_t* G;
    __device__ __forceinline__ void operator()(const f32x4 (&acc)[2][2][4][2], const Unit& u, int wr, int wc, int fr, int fq) const {
        const int row0 = u.pm * BM + wr * 64 + fr, col0 = u.pn * BM + wc * 32 + 8 * fq;
#pragma unroll
        for (int ai = 0; ai < 2; ++ai)
#pragma unroll
            for (int m = 0; m < 4; ++m) { const size_t off = (size_t)(row0 + ai * HALF + m * 16) * 1024 + col0;
#pragma unroll
                for (int bj = 0; bj < 2; ++bj) { f32x4 g0, g1, p0, p1; unpack8(*(const u32x4e*)(G + off + bj * HALF), g0, g1); unpack8(*(const u32x4e*)(U + off + bj * HALF), p0, p1);
                    *(u32x4e*)(U + off + bj * HALF) = pack8(p0 + acc[ai][bj][m][0] * g0, p1 + acc[ai][bj][m][1] * g1); } asm volatile("" ::: "memory"); }
    }
};
struct EpiFinal {
    static constexpr bool PERM = true, AFTER_DRAIN = false;
    const float* base; float* out;
    __device__ __forceinline__ void operator()(const f32x4 (&acc)[2][2][4][2], const Unit& u, int wr, int wc, int fr, int fq) const {
        const int row0 = u.pm * BM + wr * 64 + fr, col0 = u.pn * BM + wc * 32 + 8 * fq;
#pragma unroll
        for (int ai = 0; ai < 2; ++ai)
#pragma unroll
            for (int m = 0; m < 4; ++m) { const size_t off = (size_t)(row0 + ai * HALF + m * 16) * 1024 + col0;
#pragma unroll
                for (int bj = 0; bj < 2; ++bj) { const f32x4 b0 = *(const f32x4*)(base + off + bj * HALF), b1 = *(const f32x4*)(base + off + bj * HALF + 4);
                    *(f32x4*)(out + off + bj * HALF) = b0 + acc[ai][bj][m][0]; *(f32x4*)(out + off + bj * HALF + 4) = b1 + acc[ai][bj][m][1]; } asm volatile("" ::: "memory"); }
    }
};

template <class Epi, class Sched, bool ALIGN_EPI = false, bool SP2 = false>
__device__ __forceinline__ void gemm_phase(PG8_LAS unsigned char* lds, const Gemm g, const Sched& S, const Epi& E) {
    int tid_l = threadIdx.x; asm volatile("" : "+v"(tid_l));
    const int tid = tid_l, wid = __builtin_amdgcn_readfirstlane(tid >> 6), lane = tid & 63, wr = wid >> 2, wc = wid & 3, fr = lane & 15, fq = lane >> 4;
    const int K = g.K, nt = K / BK;
    unsigned voffA[2], voffB[2];
#pragma unroll
    for (int i = 0; i < 2; ++i) { int R, C; stage_rc(tid * 16 + i * 8192, R, C); const int Rb = Epi::PERM ? ((R & ~31) + perm32(R & 31)) : R;
        voffA[i] = (unsigned)(R * K + C) * 2u; voffB[i] = (unsigned)(Rb * K + C) * 2u; }
    const size_t kstep = (size_t)(BK * 2);
    const size_t hstep = (size_t)HALF * K * 2;
    const size_t tstep = 2 * hstep;
    const unsigned ldsw = (unsigned)wid * 1024u;
    const int aoff = lds_byte(wr * 64 + fr, fq * 8), boff = lds_byte(wc * 32 + fr, fq * 8);
#define PG8_SA(b, h) (((b) * 2 + (h)) * HTB)
#define PG8_SB(b, h) ((4 + (b) * 2 + (h)) * HTB)
#define PG8_STAGE(bufoff, gbase, voff) do { _Pragma("unroll") for (int _i = 0; _i < 2; ++_i) \
        __builtin_amdgcn_global_load_lds((const unsigned*)((const char*)(gbase) + (voff)[_i]), (PG8_LAS unsigned*)(lds + (bufoff) + ldsw + _i * 8192), 16, 0, 0); } while (0)
#define PG8_LDA(dst, b, h) do { _Pragma("unroll") for (int m = 0; m < 4; ++m) _Pragma("unroll") for (int k = 0; k < 2; ++k) dst[m][k] = *(const PG8_LAS bf16x8*)(lds + PG8_SA(b, h) + aoff + m * 2048 + k * 1024); } while (0)
#define PG8_LDB(dst, b, h) do { _Pragma("unroll") for (int n = 0; n < 2; ++n) _Pragma("unroll") for (int k = 0; k < 2; ++k) dst[n][k] = *(const PG8_LAS bf16x8*)(lds + PG8_SB(b, h) + boff + n * 2048 + k * 1024); } while (0)
#define PG8_MMA(ai, bj, At, Bt) do { __builtin_amdgcn_s_setprio(1); _Pragma("unroll") for (int m = 0; m < 4; ++m) _Pragma("unroll") for (int n = 0; n < 2; ++n) _Pragma("unroll") for (int k = 0; k < 2; ++k) \
        acc[ai][bj][m][n] = __builtin_amdgcn_mfma_f32_16x16x32_bf16(Bt[n][k], At[m][k], acc[ai][bj][m][n], 0, 0, 0); __builtin_amdgcn_s_setprio(0); } while (0)
#define PG8_WAIT_V(n) asm volatile("s_waitcnt vmcnt(" #n ")" ::: "memory")
#define PG8_WAIT_L(n) asm volatile("s_waitcnt lgkmcnt(" #n ")" ::: "memory")
#define PG8_BAR __builtin_amdgcn_s_barrier()
#define PG8_SCHED __builtin_amdgcn_sched_barrier(0)
    Unit cur, nxt; int ui = 0;
    if (!S.next(0, cur)) return;
    f32x4 acc[2][2][4][2];
#pragma unroll
    for (int a = 0; a < 2; ++a)
#pragma unroll
        for (int b = 0; b < 2; ++b)
#pragma unroll
            for (int m = 0; m < 4; ++m)
#pragma unroll
                for (int n = 0; n < 2; ++n) acc[a][b][m][n] = (f32x4){0.f, 0.f, 0.f, 0.f};
    bf16x8 At[4][2], B0[2][2], B1[2][2];
    const char* cA = (const char*)g.A + (size_t)cur.pm * tstep; const char* cB = (const char*)g.Bt + (size_t)cur.pn * tstep;
    S.a_ready(cur);
    if constexpr (SP2) {
        PG8_STAGE(PG8_SB(0, 0), cB, voffB); PG8_STAGE(PG8_SB(0, 1), cB + hstep, voffB); PG8_STAGE(PG8_SA(0, 0), cA, voffA); PG8_STAGE(PG8_SA(0, 1), cA + hstep, voffA);
        if (wr == 1) PG8_BAR;
        PG8_WAIT_V(2); PG8_BAR;
        PG8_STAGE(PG8_SB(1, 0), cB + kstep, voffB); PG8_STAGE(PG8_SA(1, 0), cA + kstep, voffA); PG8_STAGE(PG8_SB(1, 1), cB + hstep + kstep, voffB);
        PG8_WAIT_V(6); PG8_BAR;
    } else {
        PG8_STAGE(PG8_SB(0, 0), cB, voffB); PG8_STAGE(PG8_SA(0, 0), cA, voffA); PG8_STAGE(PG8_SB(0, 1), cB + hstep, voffB); PG8_STAGE(PG8_SA(0, 1), cA + hstep, voffA);
        if (wr == 1) PG8_BAR;
        PG8_WAIT_V(4); PG8_BAR;
        PG8_STAGE(PG8_SB(1, 0), cB + kstep, voffB); PG8_STAGE(PG8_SA(1, 0), cA + kstep, voffA); PG8_STAGE(PG8_SB(1, 1), cB + hstep + kstep, voffB);
        PG8_WAIT_V(6); PG8_BAR;
    }
    for (;;) {
        const bool has_next = S.next(ui + 1, nxt);
        const char* nA = has_next ? (const char*)g.A + (size_t)nxt.pm * tstep : cA; const char* nB = has_next ? (const char*)g.Bt + (size_t)nxt.pn * tstep : cB;
        for (int t = 0; t < nt; t += 2) {
            const bool last = (t == nt - 2);
            const char* a1 = cA + (size_t)(t + 1) * kstep;
            const char* a2 = last ? nA : cA + (size_t)(t + 2) * kstep; const char* b2 = last ? nB : cB + (size_t)(t + 2) * kstep;
            const char* a3 = a2 + kstep; const char* b3 = b2 + kstep;
            if (last && has_next) S.a_ready(nxt);
            if constexpr (SP2) {
            PG8_LDB(B0, 0, 0); PG8_LDB(B1, 0, 1); PG8_SCHED; PG8_LDA(At, 0, 0); PG8_STAGE(PG8_SA(1, 1), a1 + hstep, voffA);
            PG8_WAIT_V(8); PG8_WAIT_L(0); PG8_BAR; PG8_MMA(0, 0, At, B0); PG8_MMA(0, 1, At, B1); PG8_BAR; PG8_SCHED;
            PG8_LDA(At, 0, 1); PG8_STAGE(PG8_SB(0, 0), b2, voffB); PG8_STAGE(PG8_SB(0, 1), b2 + hstep, voffB); PG8_STAGE(PG8_SA(0, 0), a2, voffA);
            PG8_WAIT_V(8); PG8_WAIT_L(0); PG8_BAR; PG8_MMA(1, 0, At, B0); PG8_MMA(1, 1, At, B1); PG8_BAR; PG8_SCHED;
            PG8_LDB(B0, 1, 0); PG8_LDB(B1, 1, 1); PG8_SCHED; PG8_LDA(At, 1, 0); PG8_STAGE(PG8_SA(0, 1), a2 + hstep, voffA);
            PG8_WAIT_V(8); PG8_WAIT_L(0); PG8_BAR; PG8_MMA(0, 0, At, B0); PG8_MMA(0, 1, At, B1); PG8_BAR; PG8_SCHED;
            PG8_LDA(At, 1, 1); PG8_STAGE(PG8_SB(1, 0), b3, voffB); PG8_STAGE(PG8_SB(1, 1), b3 + hstep, voffB); PG8_STAGE(PG8_SA(1, 0), a3, voffA);
            PG8_WAIT_V(8); PG8_WAIT_L(0); PG8_BAR; PG8_MMA(1, 0, At, B0); PG8_MMA(1, 1, At, B1); PG8_BAR; PG8_SCHED;
            } else {
            PG8_LDB(B0, 0, 0); PG8_SCHED; PG8_LDA(At, 0, 0); PG8_STAGE(PG8_SA(1, 1), a1 + hstep, voffA);
            PG8_WAIT_L(8); PG8_BAR; PG8_WAIT_L(0); PG8_MMA(0, 0, At, B0); PG8_BAR; PG8_SCHED;
            PG8_LDB(B1, 0, 1); PG8_STAGE(PG8_SB(0, 0), b2, voffB);
            PG8_BAR; PG8_WAIT_L(0); PG8_MMA(0, 1, At, B1); PG8_BAR;
            PG8_LDA(At, 0, 1); PG8_STAGE(PG8_SA(0, 0), a2, voffA);
            PG8_BAR; PG8_WAIT_L(0); PG8_MMA(1, 0, At, B0); PG8_BAR; PG8_SCHED;
            PG8_STAGE(PG8_SB(0, 1), b2 + hstep, voffB);
            PG8_WAIT_V(6); PG8_BAR; PG8_MMA(1, 1, At, B1); PG8_BAR;
            PG8_LDB(B0, 1, 0); PG8_SCHED; PG8_LDA(At, 1, 0); PG8_STAGE(PG8_SA(0, 1), a2 + hstep, voffA);
            PG8_WAIT_L(8); PG8_BAR; PG8_WAIT_L(0); PG8_MMA(0, 0, At, B0); PG8_BAR; PG8_SCHED;
            PG8_LDB(B1, 1, 1); PG8_STAGE(PG8_SB(1, 0), b3, voffB);
            PG8_BAR; PG8_WAIT_L(0); PG8_MMA(0, 1, At, B1); PG8_BAR;
            PG8_LDA(At, 1, 1); PG8_STAGE(PG8_SA(1, 0), a3, voffA);
            PG8_BAR; PG8_WAIT_L(0); PG8_MMA(1, 0, At, B0); PG8_BAR; PG8_SCHED;
            PG8_STAGE(PG8_SB(1, 1), b3 + hstep, voffB);
            PG8_WAIT_V(6); PG8_BAR; PG8_MMA(1, 1, At, B1); PG8_BAR;
            }
        }
        if constexpr (ALIGN_EPI) { if (wr == 0) PG8_BAR; }
        if constexpr (!Epi::AFTER_DRAIN) { E(acc, cur, wr, wc, fr, fq); S.done(cur); }
        if (!has_next) break;
#pragma unroll
        for (int a = 0; a < 2; ++a)
#pragma unroll
            for (int b = 0; b < 2; ++b)
#pragma unroll
                for (int m = 0; m < 4; ++m)
#pragma unroll
                    for (int n = 0; n < 2; ++n) acc[a][b][m][n] = (f32x4){0.f, 0.f, 0.f, 0.f};
        cur = nxt; cA = nA; cB = nB; ++ui;
        if constexpr (ALIGN_EPI) { if (wr == 1) PG8_BAR; }
    }
    PG8_WAIT_V(0);
    if constexpr (!ALIGN_EPI) { if (wr == 0) PG8_BAR; }
    PG8_BAR;
    if constexpr (Epi::AFTER_DRAIN) { E.fused(acc, cur, wr, wc, fr, fq, lds, wid, lane); S.done(cur); }
#undef PG8_SA
#undef PG8_SB
#undef PG8_STAGE
#undef PG8_LDA
#undef PG8_LDB
#undef PG8_MMA
#undef PG8_WAIT_V
#undef PG8_WAIT_L
#undef PG8_BAR
#undef PG8_SCHED
}
}
#include <hip/hip_cooperative_groups.h>
namespace cg = cooperative_groups;
#define LAS __attribute__((address_space(3)))
typedef unsigned short bf16;
typedef float f32x4 __attribute__((ext_vector_type(4)));
typedef float f32x16 __attribute__((ext_vector_type(16)));
typedef short bf16x8 __attribute__((ext_vector_type(8)));
typedef unsigned u32x4 __attribute__((ext_vector_type(4)));
typedef unsigned u32x2 __attribute__((ext_vector_type(2)));

constexpr int LDS_BYTES = 147456;

struct Params {
    const float* in[16]; float* out; unsigned char* ws; float inv_freq[32]; float lam_init[2]; int pad[2];
};

__device__ __forceinline__ unsigned f2bf(float f) { unsigned u = __builtin_bit_cast(unsigned, f); return (u + 0x7fffu + ((u >> 16) & 1u)) >> 16; }
__device__ __forceinline__ unsigned pk2(float lo, float hi) { return pg8::cvt_pk_bf16(lo, hi); }
__device__ __forceinline__ float bflo(unsigned w) { return __uint_as_float(w << 16); }
__device__ __forceinline__ float bfhi(unsigned w) { return __uint_as_float(w & 0xffff0000u); }
__device__ __forceinline__ float wave_sum(float v) {
    int l = (int)__builtin_amdgcn_mbcnt_hi(~0u, __builtin_amdgcn_mbcnt_lo(~0u, 0u)); asm volatile("" : "+v"(l));
#pragma unroll
    for (int o = 1; o < 64; o <<= 1) v += __uint_as_float((unsigned)__builtin_amdgcn_ds_bpermute((l ^ o) << 2, (int)__float_as_uint(v)));
    return v;
}
__device__ __forceinline__ float wave_max(float v) {
    int l = (int)__builtin_amdgcn_mbcnt_hi(~0u, __builtin_amdgcn_mbcnt_lo(~0u, 0u)); asm volatile("" : "+v"(l));
#pragma unroll
    for (int o = 1; o < 64; o <<= 1) v = fmaxf(v, __uint_as_float((unsigned)__builtin_amdgcn_ds_bpermute((l ^ o) << 2, (int)__float_as_uint(v))));
    return v;
}
__device__ __forceinline__ float sigm(float x) { return __builtin_amdgcn_rcpf(1.0f + __expf(-x)); }

typedef const __attribute__((address_space(4))) Params* KParams;
__device__ __forceinline__ int win_logical(int pb, int& valid) {
    const int p = pb * 32; valid = 32;
    if (p < 2048) { const int sec = p >> 10, pp = p & 1023, tile = pp >> 8, x = pp & 255, bj = x >> 7, wc = (x & 127) >> 5; return sec * 1024 + tile * 256 + 64 * wc + 32 * bj; }
    if (p < 3072) return 3072 + (p - 2048);
    if (p < 4096) return 4096 + (p - 3072);
    if (p < 6144) { const int pp = p - 4096, j = pp >> 8, x = pp & 255, bj = x >> 7, xx = x & 127; return (bj == 0 ? 6160 : 7184) + 128 * j + xx; }
    if (p < 7168) return 8208 + (p - 6144);
    if (p < 8192) return 9232 + (p - 7168);
    if (p < 8448) { if (p == 8192) { valid = 16; return 6144; } valid = 0; return 0; }
    if (p < 9472) return 2048 + (p - 8448);
    return 5120 + (p - 9472);
}
__device__ __forceinline__ void transpose_item(const float* W, int N, int lc, int valid, bf16* WT, int prow0, int k0, LAS float* scr, int lane) {
#pragma unroll 8
    for (int i = 0; i < 32; ++i) { const int kk = 2 * i + (lane >> 5), c = lane & 31; scr[kk * 33 + c] = (c < valid) ? W[(size_t)(k0 + kk) * N + lc + c] : 0.f; }
    asm volatile("s_waitcnt lgkmcnt(0)" ::: "memory");
    const int c = lane & 7;
#pragma unroll
    for (int j = 0; j < 4; ++j) { const int n = (lane >> 3) + 8 * j; const LAS float* s = scr + (8 * c) * 33 + n;
        u32x4 o; o.x = pk2(s[0 * 33], s[1 * 33]); o.y = pk2(s[2 * 33], s[3 * 33]); o.z = pk2(s[4 * 33], s[5 * 33]); o.w = pk2(s[6 * 33], s[7 * 33]);
        *(u32x4*)(WT + (size_t)(prow0 + n) * 1024 + k0 + 8 * c) = o; }
    asm volatile("s_waitcnt lgkmcnt(0)" ::: "memory");
}
__device__ __forceinline__ void sincos_d(double r, double& s, double& c) {
    const double r2 = r * r; double ss = 1.0, cc = 1.0;
#pragma unroll
    for (int n = 14; n >= 1; --n) { ss = 1.0 - ss * r2 * (1.0 / (double)((2 * n) * (2 * n + 1))); cc = 1.0 - cc * r2 * (1.0 / (double)((2 * n - 1) * (2 * n))); }
    s = r * ss; c = cc;
}
__device__ __forceinline__ void prologue(KParams P, LAS unsigned char* lds, int wave, int lane) {
    LAS float* scr = (LAS float*)(lds + wave * 16384);
    const int gw = blockIdx.x * 8 + wave, NGW = gridDim.x * 8;
    constexpr int PB = WT_ROWS / 32, I_IN = PB * 16, I_SQ = 32 * 16;
    constexpr int NITEMS = NLAYER * (I_IN + 3 * I_SQ);
    for (int it = gw; it < NITEMS; it += NGW) {
        const int l = it / (I_IN + 3 * I_SQ); int r = it % (I_IN + 3 * I_SQ);
        if (r < I_IN) { const int pb = r >> 4, kb = r & 15; int valid; const int lc = win_logical(pb, valid);
            transpose_item(P->in[3] + (size_t)l * 1024 * DIN, DIN, lc, valid, (bf16*)(P->ws + WS_WTIN) + (size_t)l * WT_ROWS * 1024, pb * 32, kb * 64, scr, lane); continue; }
        r -= I_IN; const int which = r / I_SQ; r %= I_SQ; const int pb = r >> 4, kb = r & 15;
        const float* W = (which == 0 ? P->in[8] : which == 1 ? P->in[14] : P->in[15]) + (size_t)l * 1024 * 1024;
        bf16* WT = (bf16*)(P->ws + (which == 0 ? WS_WTOA : which == 1 ? WS_WTOB : WS_WTO)) + (size_t)l * 1024 * 1024;
        transpose_item(W, 1024, pb * 32, 32, WT, pb * 32, kb * 64, scr, lane);
    }
    const int* pos = (const int*)P->in[1]; float* cosT = (float*)(P->ws + WS_COS); float* sinT = (float*)(P->ws + WS_SIN);
    int t_l = threadIdx.x; asm volatile("" : "+v"(t_l)); const int gt = blockIdx.x * 512 + t_l, NT = gridDim.x * 512;
    for (int i = gt; i < NTOK * 32; i += NT) {
        const float ang = (float)pos[i >> 5] * P->inv_freq[i & 31];
        const double a = (double)ang; const double k = __builtin_rint(a * 0.15915494309189535); const double r = a - k * 6.283185307179586476925;
        double s, c; sincos_d(r, s, c); cosT[i] = (float)c; sinT[i] = (float)s;
    }
}
__device__ __forceinline__ void rmsnorm_phase(const float* xin, const float* g, bf16* H, int wave, int lane) {
    asm volatile("" : "+v"(lane));
    const int gw = blockIdx.x * 8 + wave, NGW = gridDim.x * 8;
    f32x4 gv[4];
#pragma unroll
    for (int j = 0; j < 4; ++j) gv[j] = *((const f32x4*)g + lane + 64 * j);
    for (int m = gw; m < TH; m += NGW) {
        const f32x4* xr = (const f32x4*)(xin + (size_t)m * DM) + lane; f32x4 v[4]; float s = 0.f;
#pragma unroll
        for (int j = 0; j < 4; ++j) { v[j] = xr[64 * j]; s += (v[j].x * v[j].x + v[j].y * v[j].y) + (v[j].z * v[j].z + v[j].w * v[j].w); }
        const float rs = rsqrtf(wave_sum(s) * (1.0f / DM) + EPS);
        u32x2* o8 = (u32x2*)(H + (size_t)m * DM) + lane;
#pragma unroll
        for (int j = 0; j < 4; ++j) { u32x2 w; w.x = pk2(v[j].x * rs * gv[j].x, v[j].y * rs * gv[j].y); w.y = pk2(v[j].z * rs * gv[j].z, v[j].w * rs * gv[j].w); o8[64 * j] = w; }
    }
}

__device__ __forceinline__ void gates_phase(const bf16* H, const bf16* WTg, float* GATES) {
    int t_l = threadIdx.x; asm volatile("" : "+v"(t_l));
    const int lane = t_l & 63, fr = lane & 15, fq = lane >> 4, gw = blockIdx.x * 8 + (t_l >> 6), NGW = gridDim.x * 8;
    for (int task = gw; task < TH / 16; task += NGW) {
        const bf16* ap = H + (size_t)(task * 16 + fr) * 1024 + 8 * fq; const bf16* bp = WTg + (size_t)fr * 1024 + 8 * fq;
        f32x4 acc = {0.f, 0.f, 0.f, 0.f};
#pragma unroll 8
        for (int k0 = 0; k0 < 1024; k0 += 32) acc = __builtin_amdgcn_mfma_f32_16x16x32_bf16(*(const bf16x8*)(ap + k0), *(const bf16x8*)(bp + k0), acc, 0, 0, 0);
#pragma unroll
        for (int i = 0; i < 4; ++i) GATES[(size_t)(task * 16 + 4 * fq + i) * 16 + fr] = acc[i];
    }
}
constexpr int AK_STRIDE = 72, AV_STRIDE = 72;
constexpr int AK_BYTES = 64 * AK_STRIDE * 2, AV_BYTES = 128 * AV_STRIDE * 2;
__device__ __forceinline__ int crow(int r, int hi) { return (r & 3) + 8 * (r >> 2) + 4 * hi; }
#define ATT_BAR() do { asm volatile("s_waitcnt lgkmcnt(0)" ::: "memory"); __builtin_amdgcn_s_barrier(); asm volatile("" ::: "memory"); } while (0)
__device__ __forceinline__ void attn_unit(LAS unsigned char* lds, const bf16* Q, bf16* Oo, const bf16* K, const bf16* VT, const bf16* SAZ, const float* ang, float lam, float outscale, float negshift, int bl, int h, int qb) {
    int tid_l = threadIdx.x; asm volatile("" : "+v"(tid_l));
    const int tid = tid_l, lane = tid & 63, r32 = lane & 31, hi = lane >> 5; const int wid = __builtin_amdgcn_readfirstlane(tid >> 6);
    const size_t tok0 = (size_t)bl * SEQ; const int q0 = qb * 256 + wid * 32;
    LAS bf16* Ks = (LAS bf16*)lds; LAS bf16* Vs = (LAS bf16*)(lds + 2 * AK_BYTES);
    const int NT = 4 * (qb + 1);
    const LAS bf16* ksl = Ks + r32 * AK_STRIDE + hi * 8; const LAS bf16* vsl = Vs + r32 * AV_STRIDE + hi * 8;
    LAS unsigned* o0s = (LAS unsigned*)(lds + 57344) + wid * 2048 + lane;
    const int krow_s = tid >> 3, kch = tid & 7;
    const int vpos0 = ((kch >> 1) * 4 + ((kch & 1) ? 1 : 0)) * 4, vpos1 = ((kch >> 1) * 4 + ((kch & 1) ? 3 : 2)) * 4;
#pragma unroll 1
    for (int r = 0; r < 2; ++r) {
        const bf16* Qp = Q + (tok0 + q0 + r32) * 1024 + (h * 2 + r) * 64;
        bf16x8 qr[4];
#pragma unroll
        for (int d0 = 0; d0 < 4; ++d0) qr[d0] = *(const bf16x8*)(Qp + d0 * 16 + hi * 8);
        asm volatile("" : "+v"(qr[0]), "+v"(qr[1]), "+v"(qr[2]), "+v"(qr[3]));
        const bf16* Kub = K + tok0 * 1024 + (h * 2 + r) * 64; const bf16* Vub = VT + (size_t)(h * 128) * TH + tok0;
        const unsigned klo = (unsigned)(krow_s * 1024 + kch * 8) * 2u, vlo = (unsigned)((tid >> 3) * TH + kch * 8) * 2u;
#define ATT_LDG(UB, OFF) ({ const bf16* ub_ = (UB); asm volatile("" : "+s"(ub_)); *(const u32x4*)((const char*)ub_ + (OFF)); })
        u32x4 kreg = ATT_LDG(Kub, klo), v0reg = ATT_LDG(Kub + (size_t)64 * 1024, klo), v1reg;
        *(LAS u32x4*)(Ks + krow_s * AK_STRIDE + kch * 8) = kreg;
        *(LAS u32x4*)(Ks + 64 * AK_STRIDE + krow_s * AK_STRIDE + kch * 8) = v0reg;
        ATT_BAR();
        f32x16 o[4];
#pragma unroll
        for (int b = 0; b < 4; ++b)
#pragma unroll
            for (int i = 0; i < 16; ++i) o[b][i] = 0.f;
        float lrun = 0.f;
        const int qg = q0 + r32;
        const int wlast = (q0 + 31) >> 6;
        f32x16 p0, p1; bf16x8 pf[4];
#pragma unroll
        for (int s = 0; s < 4; ++s) pf[s] = (bf16x8){0, 0, 0, 0, 0, 0, 0, 0};
#define ATT_QK(KS) do { const LAS bf16* ks_ = (KS); bf16x8 kf[8]; const f32x16 zc = {0.f, 0.f, 0.f, 0.f, 0.f, 0.f, 0.f, 0.f, 0.f, 0.f, 0.f, 0.f, 0.f, 0.f, 0.f, 0.f}; \
        _Pragma("unroll") for (int d0 = 0; d0 < 4; ++d0) { kf[2 * d0] = *(const LAS bf16x8*)(ks_ + d0 * 16); kf[2 * d0 + 1] = *(const LAS bf16x8*)(ks_ + 32 * AK_STRIDE + d0 * 16); } \
        p0 = __builtin_amdgcn_mfma_f32_32x32x16_bf16(kf[0], qr[0], zc, 0, 0, 0); p1 = __builtin_amdgcn_mfma_f32_32x32x16_bf16(kf[1], qr[0], zc, 0, 0, 0); \
        _Pragma("unroll") for (int d0 = 1; d0 < 4; ++d0) { p0 = __builtin_amdgcn_mfma_f32_32x32x16_bf16(kf[2 * d0], qr[d0], p0, 0, 0, 0); p1 = __builtin_amdgcn_mfma_f32_32x32x16_bf16(kf[2 * d0 + 1], qr[d0], p1, 0, 0, 0); } } while (0)
#define ATT_MASK(T) do { if (negshift != 0.f) { _Pragma("unroll") for (int i = 0; i < 16; ++i) { p0[i] += negshift; p1[i] += negshift; } } \
        if (64 * (T) + 63 > q0) { _Pragma("unroll") for (int i = 0; i < 16; ++i) { const int kv = 64 * (T) + crow(i, hi); if (kv > qg) p0[i] = -INFINITY; if (kv + 32 > qg) p1[i] = -INFINITY; } } } while (0)
#define ATT_SM1(P, B, DST) do { float s_ = 0.f; _Pragma("unroll") for (int i = 0; i < 8; ++i) { P[(B) + i] = __builtin_amdgcn_exp2f(P[(B) + i]); s_ += P[(B) + i]; } lrun += s_; u32x4 w_; \
        w_.x = pk2(P[(B)], P[(B) + 1]); w_.y = pk2(P[(B) + 2], P[(B) + 3]); w_.z = pk2(P[(B) + 4], P[(B) + 5]); w_.w = pk2(P[(B) + 6], P[(B) + 7]); DST = __builtin_bit_cast(bf16x8, w_); } while (0)
#define ATT_SM(PFN) do { ATT_SM1(p0, 0, PFN[0]); ATT_SM1(p0, 8, PFN[1]); ATT_SM1(p1, 0, PFN[2]); ATT_SM1(p1, 8, PFN[3]); } while (0)
#define ATT_PVL(VS) const LAS bf16* vs_ = (VS); bf16x8 vfa[4], vfb[4]; \
        _Pragma("unroll") for (int bb = 0; bb < 4; ++bb) vfa[bb] = *(const LAS bf16x8*)(vs_ + 32 * bb * AV_STRIDE);
#define ATT_PVM() do { \
        _Pragma("unroll") for (int bb = 0; bb < 4; ++bb) vfb[bb] = *(const LAS bf16x8*)(vs_ + 32 * bb * AV_STRIDE + 16); \
        _Pragma("unroll") for (int bb = 0; bb < 4; ++bb) o[bb] = __builtin_amdgcn_mfma_f32_32x32x16_bf16(vfa[bb], pf[0], o[bb], 0, 0, 0); \
        _Pragma("unroll") for (int bb = 0; bb < 4; ++bb) vfa[bb] = *(const LAS bf16x8*)(vs_ + 32 * bb * AV_STRIDE + 32); \
        _Pragma("unroll") for (int bb = 0; bb < 4; ++bb) o[bb] = __builtin_amdgcn_mfma_f32_32x32x16_bf16(vfb[bb], pf[1], o[bb], 0, 0, 0); \
        _Pragma("unroll") for (int bb = 0; bb < 4; ++bb) vfb[bb] = *(const LAS bf16x8*)(vs_ + 32 * bb * AV_STRIDE + 48); \
        _Pragma("unroll") for (int bb = 0; bb < 4; ++bb) o[bb] = __builtin_amdgcn_mfma_f32_32x32x16_bf16(vfa[bb], pf[2], o[bb], 0, 0, 0); \
        _Pragma("unroll") for (int bb = 0; bb < 4; ++bb) o[bb] = __builtin_amdgcn_mfma_f32_32x32x16_bf16(vfb[bb], pf[3], o[bb], 0, 0, 0); } while (0)
        ATT_QK(ksl);
        ATT_BAR();
#define ATT_STAGE_LD(T) do { v0reg = ATT_LDG(Vub + (T) * 64, vlo); v1reg = ATT_LDG(Vub + (size_t)64 * TH + (T) * 64, vlo); if ((T) + 2 < NT) kreg = ATT_LDG(Kub + (size_t)((T) + 2) * 64 * 1024, klo); } while (0)
#define ATT_STAGE_ST(T) do { LAS bf16* vd = Vs + ((T) & 1) * 128 * AV_STRIDE + (tid >> 3) * AV_STRIDE; \
        *(LAS u32x2*)(vd + vpos0) = (u32x2){v0reg.x, v0reg.y}; *(LAS u32x2*)(vd + vpos1) = (u32x2){v0reg.z, v0reg.w}; vd += 64 * AV_STRIDE; \
        *(LAS u32x2*)(vd + vpos0) = (u32x2){v1reg.x, v1reg.y}; *(LAS u32x2*)(vd + vpos1) = (u32x2){v1reg.z, v1reg.w}; \
        if ((T) + 2 < NT) *(LAS u32x4*)(Ks + ((T) & 1) * 64 * AK_STRIDE + krow_s * AK_STRIDE + kch * 8) = kreg; } while (0)
        {
            ATT_STAGE_LD(0);
            ATT_MASK(0); ATT_SM(pf);
            if (1 <= wlast) ATT_QK(ksl + 64 * AK_STRIDE);
            ATT_STAGE_ST(0);
            ATT_BAR();
        }
        const int tend = wlast < NT - 1 ? wlast : NT - 1;
#pragma unroll 1
        for (int t = 1; t <= tend; ++t) {
            {
                const int kt = (t + 2 < NT) ? t + 2 : NT - 1;
                v0reg = ATT_LDG(Vub + t * 64, vlo); v1reg = ATT_LDG(Vub + (size_t)64 * TH + t * 64, vlo); kreg = ATT_LDG(Kub + (size_t)kt * 64 * 1024, klo);
            }
            {
                bf16x8 pfn[4];
                ATT_PVL(vsl + ((t - 1) & 1) * 128 * AV_STRIDE)
                ATT_MASK(t);
                ATT_PVM();
                ATT_SM(pfn);
#pragma unroll
                for (int i = 0; i < 16; ++i) { __builtin_amdgcn_sched_group_barrier(0x008, 1, 0); __builtin_amdgcn_sched_group_barrier(0x400, 2, 0); __builtin_amdgcn_sched_group_barrier(0x002, 3, 0); }
#pragma unroll
                for (int s = 0; s < 4; ++s) pf[s] = pfn[s];
            }
            ATT_QK(ksl + ((t + 1) & 1) * 64 * AK_STRIDE);
            {
                LAS bf16* vd = Vs + (t & 1) * 128 * AV_STRIDE + (tid >> 3) * AV_STRIDE;
                *(LAS u32x2*)(vd + vpos0) = (u32x2){v0reg.x, v0reg.y}; *(LAS u32x2*)(vd + vpos1) = (u32x2){v0reg.z, v0reg.w}; vd += 64 * AV_STRIDE;
                *(LAS u32x2*)(vd + vpos0) = (u32x2){v1reg.x, v1reg.y}; *(LAS u32x2*)(vd + vpos1) = (u32x2){v1reg.z, v1reg.w};
                *(LAS u32x4*)(Ks + (t & 1) * 64 * AK_STRIDE + krow_s * AK_STRIDE + kch * 8) = kreg;
            }
            ATT_BAR();
        }
        if (tend < NT - 1) {
            ATT_STAGE_LD(tend + 1);
            { ATT_PVL(vsl + (tend & 1) * 128 * AV_STRIDE) ATT_PVM(); }
            ATT_STAGE_ST(tend + 1);
            ATT_BAR();
#pragma unroll 1
            for (int t = tend + 2; t < NT; ++t) { ATT_STAGE_LD(t); ATT_STAGE_ST(t); ATT_BAR(); }
        }
        if (NT - 1 <= wlast) { ATT_PVL(vsl + ((NT - 1) & 1) * 128 * AV_STRIDE) ATT_PVM(); }
#undef ATT_STAGE_LD
#undef ATT_STAGE_ST
        ATT_BAR();
#undef ATT_QK
#undef ATT_MASK
#undef ATT_SM
#undef ATT_SM1
#undef ATT_PVL
#undef ATT_PVM
#undef ATT_LDG
        const int xidx = (lane ^ 32) << 2;
        const float ltot = lrun + __uint_as_float((unsigned)__builtin_amdgcn_ds_bpermute(xidx, (int)__float_as_uint(lrun)));
        const float inv = 1.0f / ltot;
        if (r == 0) {
#pragma unroll
            for (int b = 0; b < 4; ++b)
#pragma unroll
                for (int i = 0; i < 8; ++i) o0s[(b * 8 + i) * 64] = pk2(o[b][2 * i] * inv, o[b][2 * i + 1] * inv);
        } else {
            float ss = 0.f;
#pragma unroll
            for (int b = 0; b < 4; ++b)
#pragma unroll
                for (int i = 0; i < 8; ++i) { const unsigned w = o0s[(b * 8 + i) * 64];
                    const float v0 = bflo(w) - lam * (o[b][2 * i] * inv), v1 = bfhi(w) - lam * (o[b][2 * i + 1] * inv);
                    o[b][2 * i] = v0; o[b][2 * i + 1] = v1; ss += v0 * v0 + v1 * v1; }
            ss += __uint_as_float((unsigned)__builtin_amdgcn_ds_bpermute(xidx, (int)__float_as_uint(ss)));
            const float rs = rsqrtf(ss * (1.0f / 128.0f) + EPS) * outscale;
            const bf16* Sub = SAZ + tok0 * 1024 + h * 128; bf16* Oub = Oo + tok0 * 1024 + h * 128;
            const int rowoff = (q0 + r32) * 1024;
#pragma unroll
            for (int b = 0; b < 4; ++b)
#pragma unroll
                for (int g4 = 0; g4 < 4; ++g4) {
                    const int e = 32 * b + 8 * g4 + 4 * hi;
                    const f32x4 gv = *(const f32x4*)(ang + e);
                    const u32x2 zw = *(const u32x2*)(Sub + rowoff + e);
                    u32x2 w;
                    w.x = pk2(o[b][4 * g4 + 0] * rs * gv.x * bflo(zw.x), o[b][4 * g4 + 1] * rs * gv.y * bfhi(zw.x));
                    w.y = pk2(o[b][4 * g4 + 2] * rs * gv.z * bflo(zw.y), o[b][4 * g4 + 3] * rs * gv.w * bfhi(zw.y));
                    *(u32x2*)(Oub + rowoff + e) = w;
                    if (g4 & 1) asm volatile("" ::: "memory");
                }
        }
    }
}

constexpr int ML_STRIDE = 72;
__device__ __forceinline__ void conv8(const bf16* BQK, const float* cw, const float* cb, size_t tok0, int c, int t, int ch0, float (&outv)[8]) {
    const f32x4 b0 = *(const f32x4*)(cb + ch0), b1 = *(const f32x4*)(cb + ch0 + 4);
    float a[8] = {b0.x, b0.y, b0.z, b0.w, b1.x, b1.y, b1.z, b1.w};
#pragma unroll
    for (int j = 0; j < 4; ++j) {
        const int tt = t - 3 + j;
        if (c > 0 || tt >= 0) {
            const u32x4 xv = *(const u32x4*)(BQK + (size_t)((long)tok0 + tt) * 1024 + ch0);
            const f32x4 w0 = *(const f32x4*)(cw + j * 1024 + ch0), w1 = *(const f32x4*)(cw + j * 1024 + ch0 + 4);
            a[0] += w0.x * bflo(xv.x); a[1] += w0.y * bfhi(xv.x); a[2] += w0.z * bflo(xv.y); a[3] += w0.w * bfhi(xv.y);
            a[4] += w1.x * bflo(xv.z); a[5] += w1.y * bfhi(xv.z); a[6] += w1.z * bflo(xv.w); a[7] += w1.w * bfhi(xv.w);
        }
    }
#pragma unroll
    for (int i = 0; i < 8; ++i) outv[i] = a[i] * sigm(a[i]);
}
__device__ __forceinline__ float log_sigmoid(float x) { return fminf(x, 0.f) - log1pf(__expf(-fabsf(x))); }
__device__ __forceinline__ float prefix_sum64(float v, int lane) {
#pragma unroll
    for (int o = 1; o < 64; o <<= 1) { const float n = __shfl_up(v, o); if (lane >= o) v += n; }
    return v;
}
__device__ __forceinline__ float prefix_max64(float v, int lane) {
#pragma unroll
    for (int o = 1; o < 64; o <<= 1) { const float n = __shfl_up(v, o); if (lane >= o) v = fmaxf(v, n); }
    return v;
}
__device__ __forceinline__ f32x4 mma16(const LAS bf16* A, const LAS bf16* Bt, int m0, int n0, int fr, int fq) {
    f32x4 acc = {0.f, 0.f, 0.f, 0.f};
#pragma unroll
    for (int k0 = 0; k0 < 64; k0 += 32) {
        const bf16x8 a = *(const LAS bf16x8*)(A + (m0 + fr) * ML_STRIDE + k0 + 8 * fq);
        const bf16x8 b = *(const LAS bf16x8*)(Bt + (n0 + fr) * ML_STRIDE + k0 + 8 * fq);
        acc = __builtin_amdgcn_mfma_f32_16x16x32_bf16(a, b, acc, 0, 0, 0);
    }
    return acc;
}
__device__ __forceinline__ void stage_vt(LAS bf16* Vt, const bf16* VT, int vrow0, size_t tok0, int tid) {
#pragma unroll
    for (int i = 0; i < 2; ++i) { const int idx = tid + 512 * i, e = idx >> 3, ch = idx & 7;
        *(LAS u32x4*)(Vt + e * ML_STRIDE + ch * 8) = *(const u32x4*)(VT + (size_t)(vrow0 + e) * TH + tok0 + ch * 8); }
    if (tid < 128) { const int e = 128 + (tid >> 3), ch = tid & 7; const unsigned v = (e == 128) ? 0x3f803f80u : 0u; *(LAS u32x4*)(Vt + e * ML_STRIDE + ch * 8) = (u32x4){v, v, v, v}; }
}
__device__ __forceinline__ void mlstm_m1(LAS unsigned char* lds, const bf16* BQK, const bf16* VT, const float* GATES, const float* cw, const float* cb, const float* igb, const float* fgb,
                                         float* CST, float* MST, int ci) {
    int tid_l = threadIdx.x; asm volatile("" : "+v"(tid_l));
    const int tid = tid_l, lane = tid & 63, wave = __builtin_amdgcn_readfirstlane(tid >> 6), fr = lane & 15, fq = lane >> 4;
    const int c = ci & 127, h = (ci >> 7) & 7, bl = ci >> 10; const size_t tok0 = (size_t)bl * SEQ + c * 64;
    LAS bf16* KtW = (LAS bf16*)lds; LAS bf16* Vt = (LAS bf16*)(lds + 64 * ML_STRIDE * 2); LAS float* wsh = (LAS float*)(lds + (64 + 144) * ML_STRIDE * 2);
    if (wave == 0) {
        const float fp = GATES[(tok0 + lane) * 16 + 8 + h] + fgb[h], ip = GATES[(tok0 + lane) * 16 + h] + igb[h];
        const float b = prefix_sum64(log_sigmoid(fp), lane);
        const float blast = __shfl(b, 63);
        const float wl = blast - b + ip; const float ml = wave_max(wl);
        wsh[lane] = __expf(wl - ml);
        if (lane == 0) { MST[ci * 4 + 0] = ml; MST[ci * 4 + 1] = blast; }
    }
    stage_vt(Vt, VT, 1024 + h * 128, tok0, tid);
    float kv[8]; const int t = tid >> 3, d8 = (tid & 7) * 8;
    conv8(BQK, cw, cb, tok0, c, t, 512 + h * 64 + d8, kv);
    __syncthreads();
    { const float w = wsh[t];
#pragma unroll
      for (int i = 0; i < 8; ++i) KtW[(d8 + i) * ML_STRIDE + t] = (bf16)f2bf(kv[i] * w); }
    __syncthreads();
    const int nb = wave & 3, half = wave >> 2; bf16* cst = (bf16*)CST + (size_t)ci * CST_STRIDE;
#pragma unroll
    for (int j = 0; j < 4; ++j) { const int mb = half * 4 + j; const f32x4 a = mma16(Vt, KtW, 16 * mb, 16 * nb, fr, fq);
#pragma unroll
        for (int i = 0; i < 4; ++i) cst[(16 * mb + 4 * fq + i) * 64 + 16 * nb + fr] = (bf16)f2bf(a[i]); }
    if (half == 0) { const f32x4 a = mma16(Vt, KtW, 128, 16 * nb, fr, fq); if (fq == 0) cst[128 * 64 + 16 * nb + fr] = (bf16)f2bf(a[0]); }
    __syncthreads();
}
__device__ __forceinline__ void mlstm_m2(float* CST, float* MST) {
    int t_l = threadIdx.x; asm volatile("" : "+v"(t_l));
    constexpr int NPAIR = CST_STRIDE / 2;
#pragma unroll 1
    for (int g = blockIdx.x * 512 + t_l; g < 16 * NPAIR; g += gridDim.x * 512) {
        const int seq = g / NPAIR, pr = g % NPAIR;
        float m = -1e30f, st0 = 0.f, st1 = 0.f;
        unsigned* p = (unsigned*)CST + (size_t)seq * 128 * NPAIR + pr; float* ms = MST + (size_t)seq * 128 * 4;
#pragma unroll 1
        for (int c0 = 0; c0 < 128; c0 += 16) {
            unsigned cw[16]; float ml[16], bl[16];
#pragma unroll
            for (int j = 0; j < 16; ++j) { cw[j] = p[(size_t)(c0 + j) * NPAIR]; ml[j] = ms[(c0 + j) * 4 + 0]; bl[j] = ms[(c0 + j) * 4 + 1]; }
#pragma unroll
            for (int j = 0; j < 16; ++j) {
                const float mnew = fmaxf(bl[j] + m, ml[j]); const float a = __expf(bl[j] + m - mnew), e = __expf(ml[j] - mnew);
                p[(size_t)(c0 + j) * NPAIR] = pk2(st0, st1); if (pr == 0) ms[(c0 + j) * 4 + 2] = m;
                st0 = a * st0 + e * bflo(cw[j]); st1 = a * st1 + e * bfhi(cw[j]); m = mnew;
            }
        }
    }
}
__device__ __forceinline__ void mlstm_m3(LAS unsigned char* lds, const bf16* BQK, const bf16* VT, const float* GATES, const float* cw, const float* cb, const float* igb, const float* fgb,
                                         const float* CST, const float* MST, const float* mng, const bf16* BOG, bf16* HB, int ci) {
    int tid_l = threadIdx.x; asm volatile("" : "+v"(tid_l));
    const int tid = tid_l, lane = tid & 63, wave = __builtin_amdgcn_readfirstlane(tid >> 6), fr = lane & 15, fq = lane >> 4;
    const int c = ci & 127, h = (ci >> 7) & 7, bl = ci >> 10; const size_t tok0 = (size_t)bl * SEQ + c * 64;
    constexpr int RB = ML_STRIDE * 2;
    LAS bf16* Qs = (LAS bf16*)lds; LAS bf16* Ks = (LAS bf16*)(lds + 64 * RB); LAS bf16* Vt = (LAS bf16*)(lds + 128 * RB); LAS bf16* Ct = (LAS bf16*)(lds + 272 * RB);
    LAS bf16* Ps = (LAS bf16*)(lds + 416 * RB); LAS float* Hs = (LAS float*)(lds + 480 * RB); LAS float* gsh = (LAS float*)(lds + 480 * RB + 64 * 132 * 4);
    if (wave == 0) {
        const float fp = GATES[(tok0 + lane) * 16 + 8 + h] + fgb[h], ip = GATES[(tok0 + lane) * 16 + h] + igb[h];
        const float b = prefix_sum64(log_sigmoid(fp), lane);
        const float g = ip - b; const float pm = prefix_max64(g, lane);
        const float mprev = MST[ci * 4 + 2];
        const float M = fmaxf(mprev, pm);
        gsh[lane] = g; gsh[64 + lane] = M; gsh[128 + lane] = __expf(mprev - M); gsh[192 + lane] = __expf(-(b + M));
    }
    stage_vt(Vt, VT, 1024 + h * 128, tok0, tid);
    { const bf16* cst = (const bf16*)CST + (size_t)ci * CST_STRIDE;
      for (int i = tid; i < 129 * 8; i += 512) { const int e = i >> 3, ch = i & 7; *(LAS u32x4*)(Ct + e * ML_STRIDE + ch * 8) = *(const u32x4*)(cst + e * 64 + ch * 8); }
      if (tid < 120) { const int e = 129 + (tid >> 3), ch = tid & 7; unsigned z = 0u; asm volatile("" : "+v"(z)); *(LAS u32x4*)(Ct + e * ML_STRIDE + ch * 8) = (u32x4){z, z, z, z}; } }
    { float v[8]; const int t = tid >> 3, d8 = (tid & 7) * 8;
      conv8(BQK, cw, cb, tok0, c, t, h * 64 + d8, v);
      *(LAS u32x4*)(Qs + t * ML_STRIDE + d8) = (u32x4){pk2(v[0] * 0.125f, v[1] * 0.125f), pk2(v[2] * 0.125f, v[3] * 0.125f), pk2(v[4] * 0.125f, v[5] * 0.125f), pk2(v[6] * 0.125f, v[7] * 0.125f)};
      conv8(BQK, cw, cb, tok0, c, t, 512 + h * 64 + d8, v);
      *(LAS u32x4*)(Ks + t * ML_STRIDE + d8) = (u32x4){pk2(v[0], v[1]), pk2(v[2], v[3]), pk2(v[4], v[5]), pk2(v[6], v[7])}; }
    __syncthreads();
    { const int mb = wave & 3;
#pragma unroll
      for (int j = 0; j < 2; ++j) { const int nb = (wave >> 2) * 2 + j;
          f32x4 a = {0.f, 0.f, 0.f, 0.f};
          if (nb <= mb) a = mma16(Qs, Ks, 16 * mb, 16 * nb, fr, fq);
          const int s = 16 * nb + fr; const float gs = gsh[s];
#pragma unroll
          for (int i = 0; i < 4; ++i) { const int t = 16 * mb + 4 * fq + i; const float sc = (s <= t) ? a[i] * __expf(gs - gsh[64 + t]) : 0.f; Ps[t * ML_STRIDE + s] = (bf16)f2bf(sc); } } }
    __syncthreads();
    { const int mb = wave & 3, half = wave >> 2;
      f32x4 dn = mma16(Ps, Vt, 16 * mb, 128, fr, fq); const f32x4 dn2 = mma16(Qs, Ct, 16 * mb, 128, fr, fq);
      float den[4], iwv[4], emv[4];
#pragma unroll
      for (int i = 0; i < 4; ++i) { const int t = 16 * mb + 4 * fq + i; iwv[i] = gsh[128 + t]; emv[i] = gsh[192 + t]; const float d = dn[i] + iwv[i] * dn2[i]; den[i] = __shfl(d, lane & 48); }
#pragma unroll
      for (int j = 0; j < 4; ++j) { const int eb = half * 4 + j;
          const f32x4 a1 = mma16(Ps, Vt, 16 * mb, 16 * eb, fr, fq), a2 = mma16(Qs, Ct, 16 * mb, 16 * eb, fr, fq);
#pragma unroll
          for (int i = 0; i < 4; ++i) { const int t = 16 * mb + 4 * fq + i; Hs[t * 132 + 16 * eb + fr] = (a1[i] + iwv[i] * a2[i]) / fmaxf(fabsf(den[i]), emv[i]); } } }
    __syncthreads();
#pragma unroll
    for (int j = 0; j < 8; ++j) { const int t = wave * 8 + j; const float v0 = Hs[t * 132 + 2 * lane], v1 = Hs[t * 132 + 2 * lane + 1];
        const float rs = rsqrtf(wave_sum(v0 * v0 + v1 * v1) * (1.0f / 128.0f) + EPS);
        const size_t off = (tok0 + t) * 1024 + h * 128 + 2 * lane; const unsigned gw = *(const unsigned*)(BOG + off);
        *(unsigned*)(HB + off) = pk2(v0 * rs * mng[2 * lane] * bflo(gw), v1 * rs * mng[2 * lane + 1] * bfhi(gw)); }
    __syncthreads();
}

#define XB_TMO      128
#define XB_XCNT(j)  (256  + 64 * (j))
#define XB_XSUB(j)  (1280 + 64 * (j))
#define XB_XGEN(j)  (2304 + 64 * (j))
#define XB_TOP      3328
#define XB_TOPGEN   3392
#define XCD_BAR_WORDS 3456
#define XB_SPIN_CAP (1u << 18)

__device__ __forceinline__ unsigned xb_ld(unsigned* p)              { return __hip_atomic_load(p, __ATOMIC_RELAXED, __HIP_MEMORY_SCOPE_AGENT); }
__device__ __forceinline__ unsigned xb_add(unsigned* p, unsigned v) { return __hip_atomic_fetch_add(p, v, __ATOMIC_RELAXED, __HIP_MEMORY_SCOPE_AGENT); }
__device__ __forceinline__ unsigned xb_xcc_id() { return (unsigned)__builtin_amdgcn_s_getreg((3 << 11) | 20) & 0xFu; }
#define XB_SPIN(cond, bar) do { unsigned _sp = 0; while (cond) { __builtin_amdgcn_s_sleep(1); \
    if ((++_sp & 255u) == 0u) { if (xb_ld(&(bar)[XB_TMO])) break; if (_sp > XB_SPIN_CAP) { atomicAdd(&(bar)[XB_TMO], 1u); break; } } } } while (0)

struct XcdBarrier {
    unsigned* bar; unsigned x;
    volatile LAS unsigned* st;
};

__device__ __forceinline__ XcdBarrier xcd_barrier_post(unsigned* bar, volatile LAS unsigned* st) {
    XcdBarrier b; b.bar = bar; b.x = xb_xcc_id(); b.st = st;
    if (threadIdx.x == 0) (void)xb_add(&bar[XB_XCNT(b.x)], 1u);
    return b;
}
__device__ __forceinline__ void xcd_barrier_complete(unsigned* bar, unsigned x, unsigned& nloc, unsigned& nx) {
    const unsigned G = gridDim.x * gridDim.y * gridDim.z;
    unsigned sum, cnt, mine, sp = 0u;
    for (;;) {
        sum = 0u; cnt = 0u; mine = 0u;
#pragma unroll
        for (unsigned j = 0; j < 16; ++j) { const unsigned c = xb_ld(&bar[XB_XCNT(j)]); sum += c; cnt += (c > 0u) ? 1u : 0u; mine = (j == x) ? c : mine; }
        if (sum == G) break;
        __builtin_amdgcn_s_sleep(1);
        if ((++sp & 255u) == 0u) { if (xb_ld(&bar[XB_TMO])) break; if (sp > XB_SPIN_CAP) { atomicAdd(&bar[XB_TMO], 1u); break; } }
    }
    nloc = mine > 0u ? mine : 1u; nx = cnt > 0u ? cnt : 1u;
}

__device__ __forceinline__ void xcd_barrier(const XcdBarrier& b) {
    asm volatile("s_waitcnt vmcnt(0)" ::: "memory");
    __syncthreads();
    if (threadIdx.x == 0) {
        unsigned* bar = b.bar;
        __builtin_amdgcn_s_waitcnt(0);
        unsigned nloc = b.st[0], nx = b.st[1];
        if (nloc == 0u) { xcd_barrier_complete(bar, b.x, nloc, nx); b.st[0] = nloc; b.st[1] = nx; }
        const unsigned old = xb_add(&bar[XB_XSUB(b.x)], 1u);
        const unsigned gen = old / nloc;
        if (old + 1u == (gen + 1u) * nloc) {
            __builtin_amdgcn_fence(__ATOMIC_RELEASE, "agent");
            asm volatile("s_waitcnt vmcnt(0)" ::: "memory");
            const unsigned og = xb_add(&bar[XB_TOP], 1u);
            const unsigned tg = og / nx;
            if (og + 1u == (tg + 1u) * nx) xb_add(&bar[XB_TOPGEN], 1u);
            else XB_SPIN(xb_ld(&bar[XB_TOPGEN]) == tg, bar);
            __builtin_amdgcn_fence(__ATOMIC_ACQUIRE, "agent");
            xb_add(&bar[XB_XGEN(b.x)], 1u);
            asm volatile("s_waitcnt vmcnt(0)" ::: "memory");
        } else {
            XB_SPIN(xb_ld(&bar[XB_XGEN(b.x)]) == gen, bar);
            __builtin_amdgcn_fence(__ATOMIC_ACQUIRE, "agent");
            asm volatile("s_waitcnt vmcnt(0)" ::: "memory");
        }
    }
    __syncthreads();
}
#define KPL() ({ KParams k_ = KP0; asm volatile("" : "+s"(k_)); k_; })
#define WSP(T, off) ((T*)(ws + (off)))
__device__ __forceinline__ int tid_fresh() { int t = threadIdx.x; asm volatile("" : "+v"(t)); return t; }
#ifndef NREP_B
#define NREP_B 1
#endif
#ifndef NREP_F
#define NREP_F 1
#endif
#ifndef NREP_P
#define NREP_P 1
#endif
#ifndef NREP_M
#define NREP_M 1
#endif
#ifndef NREP_ATT
#define NREP_ATT 1
#endif
#define GRID_SYNC() do { XcdBarrier xb_; xb_.bar = (unsigned*)(KPL()->ws + WS_CTL) + 4096; xb_.x = xb_xcc_id(); xb_.st = (volatile LAS unsigned*)(lds + LDS_BYTES - 64); xcd_barrier(xb_); } while (0)
__global__ void __launch_bounds__(512, 2) hybrid_fwd(Params P_unused) {
    extern __shared__ __attribute__((aligned(16))) unsigned char lds_raw[];
    LAS unsigned char* lds = (LAS unsigned char*)lds_raw;
    const KParams KP0 = (KParams)__builtin_amdgcn_kernarg_segment_ptr();
    const int G = gridDim.x, bx = blockIdx.x;
    volatile LAS unsigned* xb_st = (volatile LAS unsigned*)(lds + LDS_BYTES - 64);
    if (threadIdx.x < 2) xb_st[threadIdx.x] = 0u;
    __syncthreads();
    if (bx == 0) { unsigned* bw = (unsigned*)(KP0->ws + WS_CTL) + 4096; for (int i = threadIdx.x; i < XCD_BAR_WORDS; i += 512) __hip_atomic_store(bw + i, 0u, __ATOMIC_RELAXED, __HIP_MEMORY_SCOPE_AGENT); }
    cg::this_grid().sync();
    (void)xcd_barrier_post((unsigned*)(KP0->ws + WS_CTL) + 4096, xb_st);
#pragma unroll 1
    for (int rep = 0; rep < NREP_P; ++rep)
    { const int tid = tid_fresh(); prologue(KPL(), lds, __builtin_amdgcn_readfirstlane(tid >> 6), tid & 63); }
#pragma unroll 1
    for (int l_o = 0; l_o < NLAYER; ++l_o) {
#pragma unroll 1
        for (int hf_o = 0; hf_o < 2; ++hf_o) {
            { KParams kp = KPL(); unsigned char* ws = kp->ws; int l = l_o, hf = hf_o; asm volatile("" : "+s"(l), "+s"(hf)); (void)l; (void)hf; const int tid = tid_fresh();
              const float* xin = (l == 0 ? kp->in[0] : kp->out) + (size_t)hf * TH * DM;
              rmsnorm_phase(xin, kp->in[2] + l * DM, WSP(bf16, WS_H), __builtin_amdgcn_readfirstlane(tid >> 6), tid & 63); }
            GRID_SYNC();
#pragma unroll 1
            for (int rep = 0; rep < NREP_B; ++rep)
            { KParams kp = KPL(); unsigned char* ws = kp->ws; int l = l_o, hf = hf_o; asm volatile("" : "+s"(l), "+s"(hf)); (void)l; (void)hf;
              gates_phase(WSP(const bf16, WS_H), WSP(const bf16, WS_WTIN) + ((size_t)l * WT_ROWS + 8192) * 1024, WSP(float, WS_GATES)); }
            { KParams kp = KPL(); unsigned char* ws = kp->ws; int l = l_o, hf = hf_o; asm volatile("" : "+s"(l), "+s"(hf)); (void)l; (void)hf; const bf16* WTin = WSP(const bf16, WS_WTIN) + (size_t)l * WT_ROWS * 1024;
              { pg8::Gemm g{WSP(bf16, WS_H), WTin, TH, 8192, 1024}; pg8::StaticOrder S; S.init(TH, 8192, G, bx);
                pg8::EpiMain E{ws,
                               kp->in[4] + l * 64, kp->in[5] + l * 64, WSP(const float, WS_COS) + (size_t)hf * TH * 32, WSP(const float, WS_SIN) + (size_t)hf * TH * 32, QSCALE};
                pg8::gemm_phase<pg8::EpiMain, pg8::StaticOrder, true, true>(lds, g, S, E); }
              { pg8::Gemm g{WTin + (size_t)8448 * 1024, WSP(bf16, WS_H), 2048, TH, 1024}; pg8::StaticOrder S; S.init(2048, TH, G, bx);
                pg8::EpiPlain E{WSP(bf16, WS_VT), TH};
                pg8::gemm_phase<pg8::EpiPlain, pg8::StaticOrder, true, true>(lds, g, S, E); } }
            GRID_SYNC();
#pragma unroll 1
            for (int rep = 0; rep < NREP_M; ++rep)
            { KParams kp = KPL(); unsigned char* ws = kp->ws; int l = l_o, hf = hf_o; asm volatile("" : "+s"(l), "+s"(hf)); (void)l; (void)hf;
              for (int ci = bx; ci < NCHUNK_H; ci += G)
                  mlstm_m1(lds, WSP(bf16, WS_BQK), WSP(bf16, WS_VT), WSP(float, WS_GATES), kp->in[9] + l * 4096, kp->in[10] + l * 1024, kp->in[11] + l * 8, kp->in[12] + l * 8, WSP(float, WS_CST), WSP(float, WS_MST), ci); }
            GRID_SYNC();
            { KParams kp = KPL(); unsigned char* ws = kp->ws; int l = l_o, hf = hf_o; asm volatile("" : "+s"(l), "+s"(hf)); (void)l; (void)hf; mlstm_m2(WSP(float, WS_CST), WSP(float, WS_MST)); }
            GRID_SYNC();
#pragma unroll 1
            for (int ord = 0; ord < 2; ++ord) {
              const bool run_m3 = ((ord == 0) != (((bx >> 3) & 1) != 0));
              if (run_m3) {
#pragma unroll 1
            for (int rep = 0; rep < NREP_M; ++rep)
            { KParams kp = KPL(); unsigned char* ws = kp->ws; int l = l_o, hf = hf_o; asm volatile("" : "+s"(l), "+s"(hf)); (void)l; (void)hf;
              for (int ci = bx; ci < NCHUNK_H; ci += G)
                  mlstm_m3(lds, WSP(bf16, WS_BQK), WSP(bf16, WS_VT), WSP(float, WS_GATES), kp->in[9] + l * 4096, kp->in[10] + l * 1024, kp->in[11] + l * 8, kp->in[12] + l * 8,
                           WSP(float, WS_CST), WSP(float, WS_MST), kp->in[13] + l * 128, WSP(bf16, WS_BOG), WSP(bf16, WS_H), ci); }
              } else {
            { KParams kp = KPL(); unsigned char* ws = kp->ws; int l = l_o, hf = hf_o; asm volatile("" : "+s"(l), "+s"(hf)); (void)l; (void)hf; const int lane = tid_fresh() & 63;
              const float* lq = kp->in[6] + l * 256; const float s1 = wave_sum(lq[lane] * lq[64 + lane]), s2 = wave_sum(lq[128 + lane] * lq[192 + lane]);
              const float lam_init = kp->lam_init[l]; const float lam = __expf(s1) - __expf(s2) + lam_init;
              const float gqm = wave_max(fabsf(kp->in[4][l * 64 + lane])), gkm = wave_max(fabsf(kp->in[5][l * 64 + lane]));
              const float negshift = -fmaxf(0.f, QSCALE * 64.0f * gqm * gkm - 24.0f);
#pragma unroll 1
              for (int rep = ((l_o == 0 && hf_o == 0) ? NREP_ATT : 1) - 1; rep >= 0; --rep)
              for (int pr = bx; pr < 256; pr += G) {
                  const int pv = (G == 256) ? ((pr & 7) * 32 + (pr >> 3)) : pr;
                  const int bl = pv >> 7, h = (pv >> 4) & 7, s = pv & 15;
                  attn_unit(lds, WSP(bf16, WS_Q), rep ? (bf16*)kp->out : WSP(bf16, WS_Q), WSP(bf16, WS_K), WSP(bf16, WS_VT), WSP(bf16, WS_SAZ), kp->in[7] + l * 128, lam, 1.0f - lam_init, negshift, bl, h, 31 - s);
                  attn_unit(lds, WSP(bf16, WS_Q), rep ? (bf16*)kp->out : WSP(bf16, WS_Q), WSP(bf16, WS_K), WSP(bf16, WS_VT), WSP(bf16, WS_SAZ), kp->in[7] + l * 128, lam, 1.0f - lam_init, negshift, bl, h, s);
              } }
              }
            }
            GRID_SYNC();
#pragma unroll 1
            for (int rep = 0; rep < NREP_F; ++rep)
            { KParams kp = KPL(); unsigned char* ws = kp->ws; int l = l_o, hf = hf_o; asm volatile("" : "+s"(l), "+s"(hf)); (void)l; (void)hf;
              { pg8::Gemm g{WSP(bf16, WS_Q), WSP(const bf16, WS_WTOA) + (size_t)l * 1024 * 1024, TH, 1024, 1024}; pg8::StaticOrder S; S.init(TH, 1024, G, bx);
                pg8::EpiOutA E{WSP(bf16, WS_K), WSP(bf16, WS_SGA)};
                pg8::gemm_phase<pg8::EpiOutA, pg8::StaticOrder, true, true>(lds, g, S, E); }
              { pg8::Gemm g{WSP(bf16, WS_H), WSP(const bf16, WS_WTOB) + (size_t)l * 1024 * 1024, TH, 1024, 1024}; pg8::StaticOrder S; S.init(TH, 1024, G, bx);
                pg8::EpiOutB E{WSP(bf16, WS_K), WSP(bf16, WS_SGB)};
                pg8::gemm_phase<pg8::EpiOutB, pg8::StaticOrder, true, true>(lds, g, S, E); } }
            GRID_SYNC();
            { KParams kp = KPL(); unsigned char* ws = kp->ws; int l = l_o, hf = hf_o; asm volatile("" : "+s"(l), "+s"(hf)); (void)l; (void)hf;
              const float* xin = (l == 0 ? kp->in[0] : kp->out) + (size_t)hf * TH * DM; float* xout = kp->out + (size_t)hf * TH * DM;
              pg8::Gemm g{WSP(bf16, WS_K), WSP(const bf16, WS_WTO) + (size_t)l * 1024 * 1024, TH, 1024, 1024}; pg8::StaticOrder S; S.init(TH, 1024, G, bx);
              pg8::EpiFinal E{xin, xout};
              pg8::gemm_phase<pg8::EpiFinal, pg8::StaticOrder, true, true>(lds, g, S, E); }
            __syncthreads();
        }
    }
}

extern "C" void kernel_launch(void* const* d_in, const int* in_sizes, int n_in, void* d_out, int out_size, void* d_ws, size_t ws_size, hipStream_t stream) {
    static int grid_blocks = 0;
    if (grid_blocks == 0) {
        if (n_in != 16 || out_size != NTOK * DM || ws_size < WS_END) { fprintf(stderr, "kernel_launch: unexpected shapes / workspace (%d inputs, out %d, ws %zu)\n", n_in, out_size, ws_size); grid_blocks = -1; return; }
        int dev = 0, cus = 0, per_cu = 0;
        hipGetDevice(&dev); hipDeviceGetAttribute(&cus, hipDeviceAttributeMultiprocessorCount, dev);
        hipFuncSetAttribute((const void*)hybrid_fwd, hipFuncAttributeMaxDynamicSharedMemorySize, LDS_BYTES);
        hipOccupancyMaxActiveBlocksPerMultiprocessor(&per_cu, (const void*)hybrid_fwd, 512, LDS_BYTES);
        (void)hipGetLastError();
        if (per_cu < 1) per_cu = 1;
        grid_blocks = cus;
    }
    if (grid_blocks < 0) return;
    Params p{};
    for (int i = 0; i < 16; ++i) p.in[i] = (const float*)d_in[i];
    p.out = (float*)d_out; p.ws = (unsigned char*)d_ws;
    for (int i = 0; i < 32; ++i) p.inv_freq[i] = (float)pow(10000.0, -(double)(2 * i) / 64.0);
    for (int l = 0; l < 2; ++l) p.lam_init[l] = (float)(0.8 - 0.6 * exp(-0.3 * (double)l));
    void* args[] = {&p};
    hipError_t e = hipLaunchCooperativeKernel((void*)hybrid_fwd, dim3(grid_blocks), dim3(512), args, LDS_BYTES, stream);
    if (e != hipSuccess) fprintf(stderr, "cooperative launch failed: %s (grid %d)\n", hipGetErrorString(e), grid_blocks);
}
```
